# Optimizing an MI355X kernel written in HIP

```python
import jax, jax.numpy as jnp
from jax import lax
import numpy as np

D_MODEL = 1024
BATCH = 4
SEQ = 4096
DEPTH = 4

N_MIXERS = 2
N_MLA_LAYERS = (DEPTH + 1) // 2
N_SGU_LAYERS = DEPTH // 2
MLA_HEADS = 8
QK_NOPE_DIM = 128
QK_ROPE_DIM = 64
QK_HEAD_DIM = QK_NOPE_DIM + QK_ROPE_DIM
V_HEAD_DIM = 128
Q_LORA_RANK = 256
KV_LORA_RANK = 128
ROPE_THETA = 10000.0
Q_BLOCK = 128
SGU_CHUNK = 128
SGU_WIDTH = 2 * D_MODEL
SGU_GROUPS = 8
SGU_GROUP_DIM = SGU_WIDTH // SGU_GROUPS
FFN_HIDDEN = 4 * D_MODEL
NORM_EPS = 1e-6
LN_EPS = 1e-5

kernel_name = "hybrid_mla_chunked_sgu_trunk"


def rms_norm(x, g):
    xf = x.astype(jnp.float32)
    y = xf * lax.rsqrt(jnp.mean(xf * xf, axis=-1, keepdims=True) + NORM_EPS)
    return (y * g.astype(jnp.float32)).astype(x.dtype)


def layer_norm(x, g, b):
    xf = x.astype(jnp.float32)
    mu = jnp.mean(xf, axis=-1, keepdims=True)
    var = jnp.mean(jnp.square(xf - mu), axis=-1, keepdims=True)
    y = (xf - mu) * lax.rsqrt(var + LN_EPS)
    return (y * g.astype(jnp.float32) + b.astype(jnp.float32)).astype(x.dtype)


def apply_rope(x, cos, sin):
    x1, x2 = jnp.split(x.astype(jnp.float32), 2, axis=-1)
    out = jnp.concatenate([x1 * cos - x2 * sin, x2 * cos + x1 * sin], axis=-1)
    return out.astype(x.dtype)


def mla_mixer(h, positions, w_dkv, q_norm, kv_norm, w_uq, w_ukv, w_o):
    B, S, _ = h.shape
    lat = h @ w_dkv
    c_q, c_kv, k_rope = jnp.split(lat, [Q_LORA_RANK, Q_LORA_RANK + KV_LORA_RANK], axis=-1)
    c_q = rms_norm(c_q, q_norm)
    c_kv = rms_norm(c_kv, kv_norm)
    q = (c_q @ w_uq).reshape(B, S, MLA_HEADS, QK_HEAD_DIM)
    q_nope, q_rope = jnp.split(q, [QK_NOPE_DIM], axis=-1)
    kv = (c_kv @ w_ukv).reshape(B, S, MLA_HEADS, QK_NOPE_DIM + V_HEAD_DIM)
    k_nope, v = jnp.split(kv, [QK_NOPE_DIM], axis=-1)

    inv_freq = ROPE_THETA ** (-jnp.arange(0, QK_ROPE_DIM, 2, dtype=jnp.float32) / QK_ROPE_DIM)
    ang = positions.astype(jnp.float32)[..., None] * inv_freq
    cos, sin = jnp.cos(ang), jnp.sin(ang)
    q_rope = apply_rope(q_rope, cos[:, :, None, :], sin[:, :, None, :])
    k_rope = apply_rope(k_rope, cos, sin)

    nb = S // Q_BLOCK
    qn_b = q_nope.reshape(B, nb, Q_BLOCK, MLA_HEADS, QK_NOPE_DIM).transpose(1, 0, 2, 3, 4)
    qr_b = q_rope.reshape(B, nb, Q_BLOCK, MLA_HEADS, QK_ROPE_DIM).transpose(1, 0, 2, 3, 4)
    key_idx = jnp.arange(S)
    scale = QK_HEAD_DIM ** -0.5

    def attend(args):
        qn, qr, blk = args
        s = (jnp.einsum('bqhd,bkhd->bhqk', qn, k_nope)
             + jnp.einsum('bqhr,bkr->bhqk', qr, k_rope))
        s = s.astype(jnp.float32) * scale
        q_idx = blk * Q_BLOCK + jnp.arange(Q_BLOCK)
        causal = key_idx[None, :] <= q_idx[:, None]
        s = jnp.where(causal[None, None], s, -jnp.inf)
        p = jax.nn.softmax(s, axis=-1).astype(v.dtype)
        return jnp.einsum('bhqk,bkhd->bqhd', p, v)

    o = lax.map(attend, (qn_b, qr_b, jnp.arange(nb)))
    o = o.transpose(1, 0, 2, 3, 4).reshape(B, S, MLA_HEADS * V_HEAD_DIM)
    return o @ w_o


def chunked_sgu_mixer(h, w_in, ln_g, ln_b, w_spatial, b_spatial, w_out):
    B, S, _ = h.shape
    z = jax.nn.gelu(h @ w_in, approximate=False)
    u, v = jnp.split(z, 2, axis=-1)
    v = layer_norm(v, ln_g, ln_b)
    nc = S // SGU_CHUNK
    vg = v.reshape(B, nc, SGU_CHUNK, SGU_GROUPS, SGU_GROUP_DIM)
    w_causal = jnp.tril(w_spatial)
    mixed = (jnp.einsum('gts,bcsgd->bctgd', w_causal, vg)
             + b_spatial.T[None, None, :, :, None])
    v = mixed.reshape(B, S, SGU_WIDTH)
    return (u * v) @ w_out


def sq_relu_mlp(h, w_up, w_down):
    return jnp.square(jax.nn.relu(h @ w_up)) @ w_down


def setup_inputs(seed: int = 0) -> dict:
    key = jax.random.key(seed)
    ks = jax.random.split(key, 24)
    f32 = jnp.float32

    def nrm(k, shape, fan_in, gain=1.0):
        return jax.random.normal(k, shape, f32) * (gain * fan_in ** -0.5)

    def gain(k, shape):
        return 1.0 + 0.02 * jax.random.normal(k, shape, f32)

    x = jax.random.normal(ks[0], (BATCH, SEQ, D_MODEL), f32)
    offset = jax.random.randint(ks[1], (BATCH, 1), 0, 1024, dtype=jnp.int32)
    positions = offset + jnp.arange(SEQ, dtype=jnp.int32)[None, :]

    return {
        "x": x,
        "positions": positions,
        "norm_mix": gain(ks[2], (DEPTH, D_MODEL)),
        "norm_ffn": gain(ks[3], (DEPTH, D_MODEL)),
        "final_norm": gain(ks[4], (D_MODEL,)),
        "mla_w_dkv": nrm(ks[5], (N_MLA_LAYERS, D_MODEL, Q_LORA_RANK + KV_LORA_RANK + QK_ROPE_DIM), D_MODEL),
        "mla_q_norm": gain(ks[6], (N_MLA_LAYERS, Q_LORA_RANK)),
        "mla_kv_norm": gain(ks[7], (N_MLA_LAYERS, KV_LORA_RANK)),
        "mla_w_uq": nrm(ks[8], (N_MLA_LAYERS, Q_LORA_RANK, MLA_HEADS * QK_HEAD_DIM), Q_LORA_RANK),
        "mla_w_ukv": nrm(ks[9], (N_MLA_LAYERS, KV_LORA_RANK, MLA_HEADS * (QK_NOPE_DIM + V_HEAD_DIM)), KV_LORA_RANK),
        "mla_w_o": nrm(ks[10], (N_MLA_LAYERS, MLA_HEADS * V_HEAD_DIM, D_MODEL), MLA_HEADS * V_HEAD_DIM),
        "sgu_w_in": nrm(ks[11], (N_SGU_LAYERS, D_MODEL, 2 * SGU_WIDTH), D_MODEL),
        "sgu_ln_g": gain(ks[12], (N_SGU_LAYERS, SGU_WIDTH)),
        "sgu_ln_b": 0.02 * jax.random.normal(ks[13], (N_SGU_LAYERS, SGU_WIDTH), f32),
        "sgu_w_spatial": nrm(ks[14], (N_SGU_LAYERS, SGU_GROUPS, SGU_CHUNK, SGU_CHUNK), SGU_CHUNK, 0.5),
        "sgu_b_spatial": gain(ks[15], (N_SGU_LAYERS, SGU_GROUPS, SGU_CHUNK)),
        "sgu_w_out": nrm(ks[16], (N_SGU_LAYERS, SGU_WIDTH, D_MODEL), SGU_WIDTH),
        "ffn_w_up": nrm(ks[17], (DEPTH, D_MODEL, FFN_HIDDEN), D_MODEL),
        "ffn_w_down": nrm(ks[18], (DEPTH, FFN_HIDDEN, D_MODEL), FFN_HIDDEN),
    }


def reference(x, positions, norm_mix, norm_ffn, final_norm,
              mla_w_dkv, mla_q_norm, mla_kv_norm, mla_w_uq, mla_w_ukv, mla_w_o,
              sgu_w_in, sgu_ln_g, sgu_ln_b, sgu_w_spatial, sgu_b_spatial, sgu_w_out,
              ffn_w_up, ffn_w_down):
    for i in range(DEPTH):
        h = rms_norm(x, norm_mix[i])
        j = i // N_MIXERS
        if i % N_MIXERS == 0:
            x = x + mla_mixer(h, positions, mla_w_dkv[j], mla_q_norm[j], mla_kv_norm[j],
                              mla_w_uq[j], mla_w_ukv[j], mla_w_o[j])
        else:
            x = x + chunked_sgu_mixer(h, sgu_w_in[j], sgu_ln_g[j], sgu_ln_b[j],
                                      sgu_w_spatial[j], sgu_b_spatial[j], sgu_w_out[j])
        h = rms_norm(x, norm_ffn[i])
        x = x + sq_relu_mlp(h, ffn_w_up[i], ffn_w_down[i])
    return rms_norm(x, final_norm)
```

```cpp
#include <hip/hip_runtime.h>
#include <hip/hip_cooperative_groups.h>
#include <cstdio>
#include <cstdint>
namespace cg = cooperative_groups;

#define LAS __attribute__((address_space(3)))
typedef unsigned short bf16_t;
typedef short bf16x8 __attribute__((ext_vector_type(8)));
typedef float f32x4 __attribute__((ext_vector_type(4)));
typedef float f32x2 __attribute__((ext_vector_type(2)));
typedef float f32x16 __attribute__((ext_vector_type(16)));
typedef unsigned u32x4 __attribute__((ext_vector_type(4)));
typedef unsigned u32x2 __attribute__((ext_vector_type(2)));

constexpr int M = 16384, DM = 1024, SEQ = 4096, NH = 8, FF = 4096, SGW = 2048;
constexpr int LATK = 384;
constexpr float NORM_EPS = 1e-6f, LN_EPS = 1e-5f;
constexpr float QSCALE = 0.07216878364870322f * 1.4426950408889634f;

constexpr size_t MiB = 1u << 20;
constexpr size_t WS_SSQX = 0;
constexpr size_t WS_SSQQ = 1 * MiB;
constexpr size_t WS_SSQKV = 1 * MiB + 256 * 1024;
constexpr size_t WS_LNST = 2 * MiB;
constexpr size_t WS_COS = 4 * MiB, WS_SIN = 6 * MiB;
constexpr size_t WS_KR = 8 * MiB;
constexpr size_t WS_WSP = 10 * MiB;
constexpr size_t WS_WA = 16 * MiB;
constexpr size_t WA_LAT = 0, WA_QK = 1 * MiB, WA_V = 3 * MiB, WA_O = 4 * MiB, WA_UP = 6 * MiB, WA_DN = 14 * MiB;
constexpr size_t WS_WB = 40 * MiB;
constexpr size_t WB_INU = 0, WB_INV = 4 * MiB, WB_OUT = 8 * MiB, WB_UP = 12 * MiB, WB_DN = 20 * MiB;
constexpr size_t WS_XB = 72 * MiB;
constexpr size_t WS_HB = 104 * MiB;
constexpr size_t HB_LAT = 0, HB_QN = 16 * MiB, HB_QR = 48 * MiB, HB_KN = 64 * MiB, HB_VT = 96 * MiB;
constexpr size_t HB_U = 0, HB_VTS = 64 * MiB;
constexpr size_t WS_END = 232 * MiB;

constexpr int LDS_BYTES = 147456;

__device__ __forceinline__ unsigned cvt_pk_bf16(float lo, float hi) { unsigned r; asm volatile("v_cvt_pk_bf16_f32 %0, %1, %2" : "=v"(r) : "v"(lo), "v"(hi)); return r; }
__device__ __forceinline__ float bf2f(unsigned short b) { return __builtin_bit_cast(float, (unsigned)b << 16); }
__device__ __forceinline__ u32x4 pack8(f32x4 a, f32x4 b) { u32x4 w; w.x = cvt_pk_bf16(a[0], a[1]); w.y = cvt_pk_bf16(a[2], a[3]); w.z = cvt_pk_bf16(b[0], b[1]); w.w = cvt_pk_bf16(b[2], b[3]); return w; }
__device__ __forceinline__ float sum4(f32x4 v) { return (v[0] + v[1]) + (v[2] + v[3]); }
__device__ __forceinline__ float dot4(f32x4 v) { return (v[0] * v[0] + v[1] * v[1]) + (v[2] * v[2] + v[3] * v[3]); }
__device__ __forceinline__ f32x2 gelu_pk(f32x2 v) {
    const f32x2 av = __builtin_elementwise_abs(v), d = av * 0.2316418882f + 1.0f;
    f32x2 t; t.x = __builtin_amdgcn_rcpf(d.x); t.y = __builtin_amdgcn_rcpf(d.y);
    f32x2 q = t * 0.5307027145f + (-0.7265760135f); q = q * t + 0.7107068705f; q = q * t + (-0.142248368f); q = q * t + 0.127414796f; q = q * t;
    const f32x2 s = (v * v) * (-0.72134752044f);
    f32x2 e; e.x = __builtin_amdgcn_exp2f(s.x); e.y = __builtin_amdgcn_exp2f(s.y);
    const f32x2 m = v * (q * e), r = v - m;
    f32x2 o; o.x = v.x < 0.f ? m.x : r.x; o.y = v.y < 0.f ? m.y : r.y; return o;
}
__device__ __forceinline__ f32x4 gelu4(f32x4 v) { f32x2 a = gelu_pk((f32x2){v[0], v[1]}), b = gelu_pk((f32x2){v[2], v[3]}); return (f32x4){a.x, a.y, b.x, b.y}; }

namespace pg8 {
constexpr int BM = 256, BK = 64, HALF = 128, HTB = HALF * BK * 2, STAGE_BYTES = 8 * HTB, NXCD = 8, WGM = 8;
__device__ __forceinline__ int lds_byte(int r, int c) { const int st = (r >> 4) * 2 + (c >> 5), rr = r & 15, cc = c & 31, ob = rr * 64 + cc * 2; return st * 1024 + (ob ^ (((ob >> 9) & 1) << 5)); }
__device__ __forceinline__ void stage_rc(int b, int& R, int& C) { const int st = b / 1024, sb = b % 1024, swz = sb ^ (((sb >> 9) & 1) << 5); R = (st >> 1) * 16 + swz / 64; C = (st & 1) * 32 + (swz % 64) / 2; }
__device__ __forceinline__ int perm32(int rho) { const int n = rho >> 4, i = rho & 15; return 8 * (i >> 2) + 4 * n + (i & 3); }

struct Unit { int pm, pn; };
struct Gemm { const bf16_t* A; const bf16_t* Bt; int M, N, K, lda, ldb; };

struct StaticOrder {
    int nM, nN, nwg, G, c;
    __device__ void init(int M_, int N_, int G_, int c_) { asm volatile("" : "+s"(G_), "+s"(c_)); nM = M_ / BM; nN = N_ / BM; nwg = nM * nN; G = G_; c = c_; }
    __device__ bool next(int i, Unit& u) const {
        const long L = (long)i * G + c; if (L >= nwg) return false;
        int wgid = (int)L; { const int q = nwg / NXCD, r = nwg % NXCD, xcd = wgid % NXCD, off = wgid / NXCD; wgid = (xcd < r ? xcd * (q + 1) : r * (q + 1) + (xcd - r) * q) + off; }
        const int nig = WGM * nN, gid = wgid / nig, fm = gid * WGM, gsz = (nM - fm) < WGM ? (nM - fm) : WGM;
        u.pm = fm + ((wgid % nig) % gsz); u.pn = (wgid % nig) / gsz; return true;
    }
};

template <class Epi, class Sched>
__device__ __forceinline__ void gemm_phase(LAS unsigned char* lds, const Gemm g, const Sched& S, const Epi& E) {
    int tid_ = threadIdx.x; asm volatile("" : "+v"(tid_));
    const int tid = tid_, wid = __builtin_amdgcn_readfirstlane(tid >> 6), lane = tid & 63, wr = wid >> 2, wc = wid & 3, fr = lane & 15, fq = lane >> 4;
    int nt_ = g.K / BK; asm volatile("" : "+s"(nt_)); const int nt = nt_;
    unsigned voffA[2], voffB[2];
#pragma unroll
    for (int i = 0; i < 2; ++i) { int R, C; stage_rc(tid * 16 + i * 8192, R, C); const int Rb = (R & ~31) + perm32(R & 31);
        voffA[i] = (unsigned)(R * g.lda + C) * 2u; voffB[i] = (unsigned)(Rb * g.ldb + C) * 2u; }
    const size_t kstep = (size_t)(BK * 2);
    const size_t hA = (size_t)HALF * g.lda * 2, hB = (size_t)HALF * g.ldb * 2, tA = 2 * hA, tB = 2 * hB;
    const unsigned ldsw = (unsigned)wid * 1024u;
    const int aoff = lds_byte(wr * 64 + fr, fq * 8), boff = lds_byte(wc * 32 + fr, fq * 8);
#define PG8_SA(b, h) (((b) * 2 + (h)) * HTB)
#define PG8_SB(b, h) ((4 + (b) * 2 + (h)) * HTB)
#define PG8_STAGE(bufoff, gbase, voff) do { _Pragma("unroll") for (int _i = 0; _i < 2; ++_i) \
        __builtin_amdgcn_global_load_lds((const unsigned*)((const char*)(gbase) + (voff)[_i]), (LAS unsigned*)(lds + (bufoff) + ldsw + _i * 8192), 16, 0, 0); } while (0)
#define PG8_LDA(dst, b, h) do { _Pragma("unroll") for (int m = 0; m < 4; ++m) _Pragma("unroll") for (int k = 0; k < 2; ++k) dst[m][k] = *(const LAS bf16x8*)(lds + PG8_SA(b, h) + aoff + m * 2048 + k * 1024); } while (0)
#define PG8_LDB(dst, b, h) do { _Pragma("unroll") for (int n = 0; n < 2; ++n) _Pragma("unroll") for (int k = 0; k < 2; ++k) dst[n][k] = *(const LAS bf16x8*)(lds + PG8_SB(b, h) + boff + n * 2048 + k * 1024); } while (0)
#define PG8_MMA(ai, bj, At, Bt) do { __builtin_amdgcn_s_setprio(1); _Pragma("unroll") for (int m = 0; m < 4; ++m) _Pragma("unroll") for (int n = 0; n < 2; ++n) _Pragma("unroll") for (int k = 0; k < 2; ++k) \
        acc[ai][bj][m][n] = __builtin_amdgcn_mfma_f32_16x16x32_bf16(Bt[n][k], At[m][k], acc[ai][bj][m][n], 0, 0, 0); __builtin_amdgcn_s_setprio(0); } while (0)
#define PG8_WAIT_V(n) asm volatile("s_waitcnt vmcnt(" #n ")" ::: "memory")
#define PG8_WAIT_L(n) asm volatile("s_waitcnt lgkmcnt(" #n ")" ::: "memory")
#define PG8_BAR __builtin_amdgcn_s_barrier()
#define PG8_SCHED __builtin_amdgcn_sched_barrier(0)
    Unit cur, nxt; int ui = 0;
    if (!S.next(0, cur)) return;
    f32x4 acc[2][2][4][2];
#pragma unroll
    for (int a = 0; a < 2; ++a)
#pragma unroll
        for (int b = 0; b < 2; ++b)
#pragma unroll
            for (int m = 0; m < 4; ++m)
#pragma unroll
                for (int n = 0; n < 2; ++n) acc[a][b][m][n] = (f32x4){0.f, 0.f, 0.f, 0.f};
    bf16x8 At[4][2], B0[2][2], B1[2][2];
    const char* cA = (const char*)g.A + (size_t)cur.pm * tA; const char* cB = (const char*)g.Bt + (size_t)cur.pn * tB;
    PG8_STAGE(PG8_SB(0, 0), cB, voffB); PG8_STAGE(PG8_SB(0, 1), cB + hB, voffB); PG8_STAGE(PG8_SA(0, 0), cA, voffA); PG8_STAGE(PG8_SA(0, 1), cA + hA, voffA);
    if (wr == 1) PG8_BAR;
    PG8_WAIT_V(2); PG8_BAR;
    PG8_STAGE(PG8_SB(1, 0), cB + kstep, voffB); PG8_STAGE(PG8_SA(1, 0), cA + kstep, voffA); PG8_STAGE(PG8_SB(1, 1), cB + hB + kstep, voffB);
    PG8_WAIT_V(6); PG8_BAR;
    for (;;) {
        const bool has_next = S.next(ui + 1, nxt);
        const char* nA = has_next ? (const char*)g.A + (size_t)nxt.pm * tA : cA; const char* nB = has_next ? (const char*)g.Bt + (size_t)nxt.pn * tB : cB;
#pragma unroll 1
        for (int t = 0; t < nt; t += 2) {
            const bool last = (t == nt - 2);
            const char* a1 = cA + (size_t)(t + 1) * kstep;
            const char* a2 = last ? nA : cA + (size_t)(t + 2) * kstep; const char* b2 = last ? nB : cB + (size_t)(t + 2) * kstep;
            const char* a3 = a2 + kstep; const char* b3 = b2 + kstep;
            PG8_LDB(B0, 0, 0); PG8_LDB(B1, 0, 1); PG8_SCHED; PG8_LDA(At, 0, 0); PG8_STAGE(PG8_SA(1, 1), a1 + hA, voffA);
            PG8_WAIT_V(8); PG8_WAIT_L(0); PG8_BAR; PG8_MMA(0, 0, At, B0); PG8_MMA(0, 1, At, B1); PG8_BAR; PG8_SCHED;
            PG8_LDA(At, 0, 1); PG8_STAGE(PG8_SB(0, 0), b2, voffB); PG8_STAGE(PG8_SB(0, 1), b2 + hB, voffB); PG8_STAGE(PG8_SA(0, 0), a2, voffA);
            PG8_WAIT_V(8); PG8_WAIT_L(0); PG8_BAR; PG8_MMA(1, 0, At, B0); PG8_MMA(1, 1, At, B1); PG8_BAR; PG8_SCHED;
            PG8_LDB(B0, 1, 0); PG8_LDB(B1, 1, 1); PG8_SCHED; PG8_LDA(At, 1, 0); PG8_STAGE(PG8_SA(0, 1), a2 + hA, voffA);
            PG8_WAIT_V(8); PG8_WAIT_L(0); PG8_BAR; PG8_MMA(0, 0, At, B0); PG8_MMA(0, 1, At, B1); PG8_BAR; PG8_SCHED;
            PG8_LDA(At, 1, 1); PG8_STAGE(PG8_SB(1, 0), b3, voffB); PG8_STAGE(PG8_SB(1, 1), b3 + hB, voffB); PG8_STAGE(PG8_SA(1, 0), a3, voffA);
            PG8_WAIT_V(8); PG8_WAIT_L(0); PG8_BAR; PG8_MMA(1, 0, At, B0); PG8_MMA(1, 1, At, B1); PG8_BAR; PG8_SCHED;
        }
        if (wr == 0) PG8_BAR;
        E(acc, cur, wr, wc, fr, fq);
        if (!has_next) break;
#pragma unroll
        for (int a = 0; a < 2; ++a)
#pragma unroll
            for (int b = 0; b < 2; ++b)
#pragma unroll
                for (int m = 0; m < 4; ++m)
#pragma unroll
                    for (int n = 0; n < 2; ++n) acc[a][b][m][n] = (f32x4){0.f, 0.f, 0.f, 0.f};
        cur = nxt; cA = nA; cB = nB; ++ui;
        if (wr == 1) PG8_BAR;
    }
    PG8_WAIT_V(0);
    PG8_BAR;
#undef PG8_SA
#undef PG8_SB
#undef PG8_STAGE
#undef PG8_LDA
#undef PG8_LDB
#undef PG8_MMA
#undef PG8_WAIT_V
#undef PG8_WAIT_L
#undef PG8_BAR
#undef PG8_SCHED
}
}

typedef f32x4 Acc[2][2][4][2];

__device__ __forceinline__ float row_rx(const float* ssq, int row, int fq) {
    float s = sum4(*(const f32x4*)(ssq + (size_t)row * 16 + 4 * fq));
    s += __shfl_xor(s, 16); s += __shfl_xor(s, 32);
    return 1.0f / sqrtf(s * (1.0f / 1024.0f) + NORM_EPS);
}

struct EpiUp {
    bf16_t* O; const float* ssq;
    __device__ __forceinline__ void operator()(const Acc& acc, const pg8::Unit& u, int wr, int wc, int fr, int fq) const {
        const int row0 = u.pm * 256 + wr * 64 + fr, col0 = u.pn * 256 + wc * 32 + 8 * fq;
#pragma unroll
        for (int ai = 0; ai < 2; ++ai)
#pragma unroll
            for (int m = 0; m < 4; ++m) { const int row = row0 + ai * 128 + m * 16; const float r = row_rx(ssq, row, fq);
#pragma unroll
                for (int bj = 0; bj < 2; ++bj) { f32x4 v0 = acc[ai][bj][m][0] * r, v1 = acc[ai][bj][m][1] * r;
                    v0 = __builtin_elementwise_max(v0, (f32x4){0.f, 0.f, 0.f, 0.f}); v1 = __builtin_elementwise_max(v1, (f32x4){0.f, 0.f, 0.f, 0.f});
                    *(u32x4*)(O + (size_t)row * FF + col0 + bj * 128) = pack8(v0 * v0, v1 * v1); } asm volatile("" ::: "memory"); }
    }
};
struct EpiU {
    bf16_t* O; const float* ssq;
    __device__ __forceinline__ void operator()(const Acc& acc, const pg8::Unit& u, int wr, int wc, int fr, int fq) const {
        const int row0 = u.pm * 256 + wr * 64 + fr, col0 = u.pn * 256 + wc * 32 + 8 * fq;
#pragma unroll
        for (int ai = 0; ai < 2; ++ai)
#pragma unroll
            for (int m = 0; m < 4; ++m) { const int row = row0 + ai * 128 + m * 16; const float r = row_rx(ssq, row, fq);
#pragma unroll
                for (int bj = 0; bj < 2; ++bj) { const f32x4 v0 = gelu4(acc[ai][bj][m][0] * r), v1 = gelu4(acc[ai][bj][m][1] * r);
                    *(u32x4*)(O + (size_t)row * SGW + col0 + bj * 128) = pack8(v0, v1); } asm volatile("" ::: "memory"); }
    }
};
struct EpiRes {
    const float* xin; float* xout; bf16_t* xb; float* ssq;
    __device__ __forceinline__ void operator()(const Acc& acc, const pg8::Unit& u, int wr, int wc, int fr, int fq) const {
        const int row0 = u.pm * 256 + wr * 64 + fr, col0 = u.pn * 256 + wc * 32 + 8 * fq;
#pragma unroll
        for (int ai = 0; ai < 2; ++ai)
#pragma unroll
            for (int m = 0; m < 4; ++m) { const int row = row0 + ai * 128 + m * 16; float s = 0.f;
#pragma unroll
                for (int bj = 0; bj < 2; ++bj) { const size_t p = (size_t)row * DM + col0 + bj * 128;
                    const f32x4 x0 = *(const f32x4*)(xin + p) + acc[ai][bj][m][0], x1 = *(const f32x4*)(xin + p + 4) + acc[ai][bj][m][1];
                    *(f32x4*)(xout + p) = x0; *(f32x4*)(xout + p + 4) = x1; *(u32x4*)(xb + p) = pack8(x0, x1); s += dot4(x0) + dot4(x1); }
                s += __shfl_xor(s, 16); s += __shfl_xor(s, 32);
                if (fq == 0) ssq[(size_t)row * 16 + u.pn * 4 + wc] = s; asm volatile("" ::: "memory"); }
    }
};
struct EpiLat {
    bf16_t* lat; bf16_t* kr; const float* ssqx; float* ssqq; float* ssqkv; const float* cs; const float* sn;
    __device__ __forceinline__ void operator()(const Acc& acc, const pg8::Unit& u, int wr, int wc, int fr, int fq) const {
        const int row0 = u.pm * 256 + wr * 64 + fr;
#pragma unroll
        for (int ai = 0; ai < 2; ++ai)
#pragma unroll
            for (int m = 0; m < 4; ++m) { const int row = row0 + ai * 128 + m * 16; const float r = row_rx(ssqx, row, fq);
                const f32x4 a0 = acc[ai][0][m][0] * r, a1 = acc[ai][0][m][1] * r, b0 = acc[ai][1][m][0] * r, b1 = acc[ai][1][m][1] * r;
                if (u.pn == 0) {
                    bf16_t* o = lat + (size_t)row * LATK + wc * 32 + 8 * fq;
                    *(u32x4*)o = pack8(a0, a1); *(u32x4*)(o + 128) = pack8(b0, b1);
                    float s = dot4(a0) + dot4(a1) + dot4(b0) + dot4(b1); s += __shfl_xor(s, 16); s += __shfl_xor(s, 32);
                    if (fq == 0) ssqq[(size_t)row * 4 + wc] = s;
                } else if (wc < 2) {
                    bf16_t* o = lat + (size_t)row * LATK + 256 + wc * 32 + 8 * fq;
                    *(u32x4*)o = pack8(a0, a1); *(u32x4*)(o + 64) = pack8(b0, b1);
                    float s = dot4(a0) + dot4(a1) + dot4(b0) + dot4(b1); s += __shfl_xor(s, 16); s += __shfl_xor(s, 32);
                    if (fq == 0) { ssqkv[(size_t)row * 4 + wc] = s; ssqkv[(size_t)row * 4 + 2 + wc] = 0.f; }
                } else if (wc == 2) {
                    const float* cp = cs + (size_t)row * 32 + 8 * fq; const float* sp = sn + (size_t)row * 32 + 8 * fq;
                    const f32x4 c0 = *(const f32x4*)cp, c1 = *(const f32x4*)(cp + 4), s0 = *(const f32x4*)sp, s1 = *(const f32x4*)(sp + 4);
                    bf16_t* o = kr + (size_t)row * 64 + 8 * fq;
                    *(u32x4*)o = pack8(a0 * c0 - b0 * s0, a1 * c1 - b1 * s1);
                    *(u32x4*)(o + 32) = pack8(b0 * c0 + a0 * s0, b1 * c1 + a1 * s1);
                }
                asm volatile("" ::: "memory");
            }
    }
};
struct EpiQK {
    bf16_t* qn; bf16_t* qr; bf16_t* kn; const float* ssqq; const float* ssqkv; const float* cs; const float* sn;
    __device__ __forceinline__ void operator()(const Acc& acc, const pg8::Unit& u, int wr, int wc, int fr, int fq) const {
        const int row0 = u.pm * 256 + wr * 64 + fr;
#pragma unroll
        for (int ai = 0; ai < 2; ++ai)
#pragma unroll
            for (int m = 0; m < 4; ++m) { const int row = row0 + ai * 128 + m * 16;
                const bool isq = u.pn < 6;
                const float ss = sum4(*(const f32x4*)((isq ? ssqq : ssqkv) + (size_t)row * 4));
                const float r = (isq ? QSCALE : 1.0f) / sqrtf(ss * (isq ? (1.0f / 256.0f) : (1.0f / 128.0f)) + NORM_EPS);
                const f32x4 a0 = acc[ai][0][m][0] * r, a1 = acc[ai][0][m][1] * r, b0 = acc[ai][1][m][0] * r, b1 = acc[ai][1][m][1] * r;
                if (u.pn < 4) {
                    bf16_t* o = qn + (size_t)row * 1024 + u.pn * 256 + wc * 32 + 8 * fq;
                    *(u32x4*)o = pack8(a0, a1); *(u32x4*)(o + 128) = pack8(b0, b1);
                } else if (u.pn < 6) {
                    const float* cp = cs + (size_t)row * 32 + 8 * fq; const float* sp = sn + (size_t)row * 32 + 8 * fq;
                    const f32x4 c0 = *(const f32x4*)cp, c1 = *(const f32x4*)(cp + 4), s0 = *(const f32x4*)sp, s1 = *(const f32x4*)(sp + 4);
                    bf16_t* o = qr + (size_t)row * 512 + ((u.pn - 4) * 4 + wc) * 64 + 8 * fq;
                    *(u32x4*)o = pack8(a0 * c0 - b0 * s0, a1 * c1 - b1 * s1);
                    *(u32x4*)(o + 32) = pack8(b0 * c0 + a0 * s0, b1 * c1 + a1 * s1);
                } else {
                    bf16_t* o = kn + (size_t)row * 1024 + (u.pn - 6) * 256 + wc * 32 + 8 * fq;
                    *(u32x4*)o = pack8(a0, a1); *(u32x4*)(o + 128) = pack8(b0, b1);
                }
                asm volatile("" ::: "memory");
            }
    }
};
struct EpiVT {
    bf16_t* vt; const float* ssqkv;
    __device__ __forceinline__ void operator()(const Acc& acc, const pg8::Unit& u, int wr, int wc, int fr, int fq) const {
        const int lane = threadIdx.x & 63;
        const int tokb = u.pn * 256 + wc * 32 + 8 * fq;
        float rmine; { const int tok = tokb + (fr >> 3) * 128 + (fr & 7); rmine = 1.0f / sqrtf(sum4(*(const f32x4*)(ssqkv + (size_t)tok * 4)) * (1.0f / 128.0f) + NORM_EPS); }
        const int f0 = u.pm * 256 + wr * 64 + fr;
#pragma unroll
        for (int bj = 0; bj < 2; ++bj) {
            f32x4 r0, r1;
#pragma unroll
            for (int e = 0; e < 4; ++e) { r0[e] = __shfl(rmine, (lane & 48) | (bj * 8 + e)); r1[e] = __shfl(rmine, (lane & 48) | (bj * 8 + 4 + e)); }
            const int g16 = u.pn * 256 + bj * 128 + wc * 32 + (fq >> 1) * 16;
#pragma unroll
            for (int ai = 0; ai < 2; ++ai)
#pragma unroll
                for (int m = 0; m < 4; ++m) { const int f = f0 + ai * 128 + m * 16;
                    const f32x4 v0 = acc[ai][bj][m][0] * r0, v1 = acc[ai][bj][m][1] * r1;
                    bf16_t* o = vt + (size_t)f * M + g16 + 4 * (fq & 1);
                    u32x2 w0, w1; w0.x = cvt_pk_bf16(v0[0], v0[1]); w0.y = cvt_pk_bf16(v0[2], v0[3]); w1.x = cvt_pk_bf16(v1[0], v1[1]); w1.y = cvt_pk_bf16(v1[2], v1[3]);
                    *(u32x2*)o = w0; *(u32x2*)(o + 8) = w1; asm volatile("" ::: "memory"); }
        }
    }
};
struct EpiVTS {
    bf16_t* vt; const float* ssqx; float* lnst;
    __device__ __forceinline__ void operator()(const Acc& acc, const pg8::Unit& u, int wr, int wc, int fr, int fq) const {
        const int lane = threadIdx.x & 63;
        const int tokb = u.pn * 256 + wc * 32 + 8 * fq;
        float rmine; { const int tok = tokb + (fr >> 3) * 128 + (fr & 7); const float* p = ssqx + (size_t)tok * 16;
            const float s = (sum4(*(const f32x4*)p) + sum4(*(const f32x4*)(p + 4))) + (sum4(*(const f32x4*)(p + 8)) + sum4(*(const f32x4*)(p + 12)));
            rmine = 1.0f / sqrtf(s * (1.0f / 1024.0f) + NORM_EPS); }
        const int f0 = u.pm * 256 + wr * 64 + fr;
#pragma unroll
        for (int bj = 0; bj < 2; ++bj) {
            f32x4 r0, r1;
#pragma unroll
            for (int e = 0; e < 4; ++e) { r0[e] = __shfl(rmine, (lane & 48) | (bj * 8 + e)); r1[e] = __shfl(rmine, (lane & 48) | (bj * 8 + 4 + e)); }
            f32x4 s10 = {0.f, 0.f, 0.f, 0.f}, s11 = s10, s20 = s10, s21 = s10;
            const int tok0 = tokb + bj * 128;
#pragma unroll
            for (int ai = 0; ai < 2; ++ai)
#pragma unroll
                for (int m = 0; m < 4; ++m) { const int f = f0 + ai * 128 + m * 16;
                    const f32x4 v0 = gelu4(acc[ai][bj][m][0] * r0), v1 = gelu4(acc[ai][bj][m][1] * r1);
                    *(u32x4*)(vt + (size_t)f * M + tok0) = pack8(v0, v1);
                    s10 += v0; s11 += v1; s20 += v0 * v0; s21 += v1 * v1; asm volatile("" ::: "memory"); }
#pragma unroll
            for (int o = 1; o < 16; o <<= 1) {
#pragma unroll
                for (int e = 0; e < 4; ++e) { s10[e] += __shfl_xor(s10[e], o); s11[e] += __shfl_xor(s11[e], o); s20[e] += __shfl_xor(s20[e], o); s21[e] += __shfl_xor(s21[e], o); } }
            if (fr == 0) {
                const int slot = u.pm * 2 + wr;
#pragma unroll
                for (int e = 0; e < 4; ++e) {
                    *(f32x2*)(lnst + ((size_t)(tok0 + e) * 16 + slot) * 2) = (f32x2){s10[e], s20[e]};
                    *(f32x2*)(lnst + ((size_t)(tok0 + 4 + e) * 16 + slot) * 2) = (f32x2){s11[e], s21[e]}; }
            }
        }
    }
};

namespace att {
constexpr int KROW = 200, VROW = 72, KBYTES = 64 * KROW * 2, VBYTES = 128 * VROW * 2, BUFB = KBYTES + VBYTES;
__device__ __forceinline__ int crow(int r, int hi) { return (r & 3) + 8 * (r >> 2) + 4 * hi; }

__device__ __forceinline__ void attn_unit(LAS unsigned char* lds, int b, int h, int qb, const bf16_t* Qn, const bf16_t* Qr, const bf16_t* __restrict__ Kn,
                                          const bf16_t* __restrict__ Kr, const bf16_t* __restrict__ Vt, bf16_t* O) {
    int tid_ = threadIdx.x; asm volatile("" : "+v"(tid_));
    const int tid = tid_, lane = tid & 63, r32 = lane & 31, hi = lane >> 5, wid = __builtin_amdgcn_readfirstlane(tid >> 6);
    const int tok0 = b * SEQ, q0 = qb * 256;
    const int qtok = tok0 + q0 + wid * 32 + r32;
    bf16x8 qf[12];
#pragma unroll
    for (int ks = 0; ks < 8; ++ks) qf[ks] = *(const bf16x8*)(Qn + (size_t)qtok * 1024 + h * 128 + ks * 16 + hi * 8);
#pragma unroll
    for (int ks = 0; ks < 4; ++ks) qf[8 + ks] = *(const bf16x8*)(Qr + (size_t)qtok * 512 + h * 64 + ks * 16 + hi * 8);
    f32x16 o[4];
#pragma unroll
    for (int d = 0; d < 4; ++d)
#pragma unroll
        for (int r = 0; r < 16; ++r) o[d][r] = 0.f;
    float mrow = -INFINITY, lrow = 0.f;
    const int NT = 4 * (qb + 1);
    u32x4 st[5];
    const int krow0 = tid >> 4, kcc = tid & 15, rrow = tid >> 3, rcc = tid & 7;
    const bf16_t* kn_src = Kn + (size_t)(tok0 + krow0) * 1024 + h * 128 + kcc * 8;
    const bf16_t* kr_src = Kr + (size_t)(tok0 + rrow) * 64 + rcc * 8;
    const bf16_t* vt_src = Vt + (size_t)(h * 128 + rrow) * M + tok0 + rcc * 8;
#define ATT_LOAD(j) do { const size_t tb_ = (size_t)(j) * 64; \
        st[0] = *(const u32x4*)(kn_src + tb_ * 1024); st[1] = *(const u32x4*)(kn_src + (tb_ + 32) * 1024); \
        st[2] = *(const u32x4*)(kr_src + tb_ * 64); \
        st[3] = *(const u32x4*)(vt_src + tb_); st[4] = *(const u32x4*)(vt_src + (size_t)64 * M + tb_); } while (0)
#define ATT_STORE(buf) do { LAS unsigned char* ks_ = lds + (buf) * BUFB; LAS unsigned char* vs_ = ks_ + KBYTES; \
        *(LAS u32x4*)(ks_ + (krow0 * KROW + kcc * 8) * 2) = st[0]; *(LAS u32x4*)(ks_ + ((krow0 + 32) * KROW + kcc * 8) * 2) = st[1]; \
        *(LAS u32x4*)(ks_ + (rrow * KROW + 128 + rcc * 8) * 2) = st[2]; \
        *(LAS u32x4*)(vs_ + (rrow * VROW + rcc * 8) * 2) = st[3]; *(LAS u32x4*)(vs_ + ((rrow + 64) * VROW + rcc * 8) * 2) = st[4]; } while (0)
    ATT_LOAD(0);
    for (int j = 0; j < NT; ++j) {
        const int buf = j & 1;
        ATT_STORE(buf);
        __syncthreads();
        if (j + 1 < NT) ATT_LOAD(j + 1);
        const LAS unsigned char* kp = lds + buf * BUFB + (r32 * KROW + hi * 8) * 2;
        const LAS unsigned char* vp = lds + buf * BUFB + KBYTES + (r32 * VROW + hi * 8) * 2;
        f32x16 p0, p1;
#pragma unroll
        for (int r = 0; r < 16; ++r) { p0[r] = 0.f; p1[r] = 0.f; }
#pragma unroll
        for (int ks = 0; ks < 12; ++ks) {
            const bf16x8 a0 = *(const LAS bf16x8*)(kp + ks * 32), a1 = *(const LAS bf16x8*)(kp + 32 * KROW * 2 + ks * 32);
            p0 = __builtin_amdgcn_mfma_f32_32x32x16_bf16(a0, qf[ks], p0, 0, 0, 0);
            p1 = __builtin_amdgcn_mfma_f32_32x32x16_bf16(a1, qf[ks], p1, 0, 0, 0);
        }
        const int jb = j - (NT - 4);
        if (jb >= 0 && 64 * jb + 63 > wid * 32) {
            const int qrel = wid * 32 + r32, kb = 64 * jb + 4 * hi;
#pragma unroll
            for (int r = 0; r < 16; ++r) { const int kv = kb + (r & 3) + 8 * (r >> 2); if (kv > qrel) p0[r] = -INFINITY; if (kv + 32 > qrel) p1[r] = -INFINITY; }
        }
        float mx = fmaxf(p0[0], p1[0]);
#pragma unroll
        for (int r = 1; r < 16; ++r) mx = fmaxf(mx, fmaxf(p0[r], p1[r]));
        mx = fmaxf(mx, __shfl_xor(mx, 32));
        const float mnew = fmaxf(mrow, mx);
        const float alpha = __builtin_amdgcn_exp2f(mrow - mnew);
        mrow = mnew;
        float ls = 0.f;
#pragma unroll
        for (int r = 0; r < 16; ++r) { p0[r] = __builtin_amdgcn_exp2f(p0[r] - mnew); p1[r] = __builtin_amdgcn_exp2f(p1[r] - mnew); ls += p0[r] + p1[r]; }
        lrow = lrow * alpha + ls;
#pragma unroll
        for (int d = 0; d < 4; ++d)
#pragma unroll
            for (int r = 0; r < 16; ++r) o[d][r] *= alpha;
        bf16x8 pk[4];
        { u32x4 w;
          w.x = cvt_pk_bf16(p0[0], p0[1]); w.y = cvt_pk_bf16(p0[2], p0[3]); w.z = cvt_pk_bf16(p0[4], p0[5]); w.w = cvt_pk_bf16(p0[6], p0[7]); pk[0] = __builtin_bit_cast(bf16x8, w);
          w.x = cvt_pk_bf16(p0[8], p0[9]); w.y = cvt_pk_bf16(p0[10], p0[11]); w.z = cvt_pk_bf16(p0[12], p0[13]); w.w = cvt_pk_bf16(p0[14], p0[15]); pk[1] = __builtin_bit_cast(bf16x8, w);
          w.x = cvt_pk_bf16(p1[0], p1[1]); w.y = cvt_pk_bf16(p1[2], p1[3]); w.z = cvt_pk_bf16(p1[4], p1[5]); w.w = cvt_pk_bf16(p1[6], p1[7]); pk[2] = __builtin_bit_cast(bf16x8, w);
          w.x = cvt_pk_bf16(p1[8], p1[9]); w.y = cvt_pk_bf16(p1[10], p1[11]); w.z = cvt_pk_bf16(p1[12], p1[13]); w.w = cvt_pk_bf16(p1[14], p1[15]); pk[3] = __builtin_bit_cast(bf16x8, w); }
#pragma unroll
        for (int d = 0; d < 4; ++d)
#pragma unroll
            for (int ks = 0; ks < 4; ++ks) {
                const bf16x8 a = *(const LAS bf16x8*)(vp + d * 32 * VROW * 2 + ks * 32);
                o[d] = __builtin_amdgcn_mfma_f32_32x32x16_bf16(a, pk[ks], o[d], 0, 0, 0);
            }
    }
#undef ATT_LOAD
#undef ATT_STORE
    const float ltot = lrow + __shfl_xor(lrow, 32);
    const float inv = 1.0f / ltot;
    bf16_t* op = O + (size_t)qtok * 1024 + h * 128 + 4 * hi;
#pragma unroll
    for (int d = 0; d < 4; ++d)
#pragma unroll
        for (int rg = 0; rg < 4; ++rg) { u32x2 w; w.x = cvt_pk_bf16(o[d][4 * rg] * inv, o[d][4 * rg + 1] * inv); w.y = cvt_pk_bf16(o[d][4 * rg + 2] * inv, o[d][4 * rg + 3] * inv);
            *(u32x2*)(op + 32 * d + 8 * rg) = w; }
}
}

namespace sgu {
constexpr int AROW = 136;
constexpr int A_BYTES = 256 * AROW * 2, B_BYTES = 128 * AROW * 2, ST_OFF = A_BYTES + B_BYTES;
__device__ __forceinline__ void item(LAS unsigned char* lds, int c, int g, const bf16_t* __restrict__ vT, const float* __restrict__ lnst, const float* __restrict__ lng,
                                     const float* __restrict__ lnb, const bf16_t* __restrict__ wsp, const float* __restrict__ bsp, bf16_t* U) {
    int tid_ = threadIdx.x; asm volatile("" : "+v"(tid_));
    const int tid = tid_, lane = tid & 63, r32 = lane & 31, hi = lane >> 5, wid = __builtin_amdgcn_readfirstlane(tid >> 6);
    const int tokbase = c * 128;
    LAS float* mu = (LAS float*)(lds + ST_OFF); LAS float* rs = mu + 128;
    if (tid < 128) {
        const float* p = lnst + (size_t)(tokbase + tid) * 32; float s1 = 0.f, s2 = 0.f;
#pragma unroll
        for (int i = 0; i < 8; ++i) { const f32x4 v = *(const f32x4*)(p + 4 * i); s1 += v[0] + v[2]; s2 += v[1] + v[3]; }
        const float mean = s1 * (1.0f / 2048.0f), var = fmaxf(s2 * (1.0f / 2048.0f) - mean * mean, 0.f);
        mu[tid] = mean; rs[tid] = 1.0f / sqrtf(var + LN_EPS);
    }
#pragma unroll
    for (int i = 0; i < 4; ++i) { const int ch = tid + 512 * i, t = ch >> 4, cc = ch & 15;
        *(LAS u32x4*)(lds + A_BYTES + (t * AROW + cc * 8) * 2) = *(const u32x4*)(wsp + ((size_t)g * 128 + t) * 128 + cc * 8); }
    __syncthreads();
#pragma unroll
    for (int i = 0; i < 8; ++i) { const int ch = tid + 512 * i, d = ch >> 4, cc = ch & 15;
        const u32x4 raw = *(const u32x4*)(vT + (size_t)(g * 256 + d) * M + tokbase + cc * 8);
        const float gg = lng[g * 256 + d], bb = lnb[g * 256 + d];
        float v[8];
#pragma unroll
        for (int e = 0; e < 4; ++e) { const unsigned w = raw[e]; v[2 * e] = __builtin_bit_cast(float, w << 16); v[2 * e + 1] = __builtin_bit_cast(float, w & 0xffff0000u); }
#pragma unroll
        for (int e = 0; e < 8; ++e) { const int s = cc * 8 + e; v[e] = (v[e] - mu[s]) * rs[s] * gg + bb; }
        u32x4 w; w.x = cvt_pk_bf16(v[0], v[1]); w.y = cvt_pk_bf16(v[2], v[3]); w.z = cvt_pk_bf16(v[4], v[5]); w.w = cvt_pk_bf16(v[6], v[7]);
        *(LAS u32x4*)(lds + (d * AROW + cc * 8) * 2) = w; }
    __syncthreads();
    f32x16 acc[4];
#pragma unroll
    for (int tb = 0; tb < 4; ++tb)
#pragma unroll
        for (int r = 0; r < 16; ++r) acc[tb][r] = 0.f;
    const LAS unsigned char* ap = lds + ((wid * 32 + r32) * AROW + hi * 8) * 2;
    const LAS unsigned char* bp = lds + A_BYTES + (r32 * AROW + hi * 8) * 2;
#pragma unroll
    for (int ks = 0; ks < 8; ++ks) {
        const bf16x8 a = *(const LAS bf16x8*)(ap + ks * 32);
#pragma unroll
        for (int tb = 0; tb < 4; ++tb) if (16 * ks <= 32 * tb + 31) {
            const bf16x8 bq = *(const LAS bf16x8*)(bp + tb * 32 * AROW * 2 + ks * 32);
            acc[tb] = __builtin_amdgcn_mfma_f32_32x32x16_bf16(a, bq, acc[tb], 0, 0, 0);
        }
    }
#pragma unroll
    for (int tb = 0; tb < 4; ++tb) { const int t = tb * 32 + r32; const float bias = bsp[g * 128 + t];
        bf16_t* up = U + (size_t)(tokbase + t) * SGW + g * 256 + wid * 32 + 4 * hi;
#pragma unroll
        for (int rg = 0; rg < 4; ++rg) { const u32x2 uu = *(const u32x2*)(up + 8 * rg);
            const float u0 = __builtin_bit_cast(float, uu.x << 16), u1 = __builtin_bit_cast(float, uu.x & 0xffff0000u), u2 = __builtin_bit_cast(float, uu.y << 16), u3 = __builtin_bit_cast(float, uu.y & 0xffff0000u);
            u32x2 w; w.x = cvt_pk_bf16(u0 * (acc[tb][4 * rg] + bias), u1 * (acc[tb][4 * rg + 1] + bias)); w.y = cvt_pk_bf16(u2 * (acc[tb][4 * rg + 2] + bias), u3 * (acc[tb][4 * rg + 3] + bias));
            *(u32x2*)(up + 8 * rg) = w; } }
    __syncthreads();
}
}

__device__ __forceinline__ float wave_sum(float v) {
#pragma unroll
    for (int o = 1; o < 64; o <<= 1) v += __shfl_xor(v, o);
    return v;
}
template <class F>
__device__ __forceinline__ void conv_matrix(const F& f, bf16_t* WT, int Kd, int Nd, LAS float* scr, int gw, int NGW, int lane_) {
    (void)lane_; int lt_ = threadIdx.x; asm volatile("" : "+v"(lt_)); const int lane = lt_ & 63;
    const int nblk = Nd / 32, nitems = (Kd / 64) * nblk;
    for (int it = gw; it < nitems; it += NGW) {
        const int kb = it / nblk, nb = it % nblk, k0 = 64 * kb, n0 = 32 * nb;
#pragma unroll 8
        for (int i = 0; i < 32; ++i) { const int kk = 2 * i + (lane >> 5); scr[kk * 33 + (lane & 31)] = f(k0 + kk, n0 + (lane & 31)); }
        asm volatile("s_waitcnt lgkmcnt(0)" ::: "memory");
        const int c = lane & 7;
#pragma unroll
        for (int j = 0; j < 4; ++j) { const int n = (lane >> 3) + 8 * j; const LAS float* s = scr + (8 * c) * 33 + n;
            u32x4 o; o.x = cvt_pk_bf16(s[0 * 33], s[1 * 33]); o.y = cvt_pk_bf16(s[2 * 33], s[3 * 33]); o.z = cvt_pk_bf16(s[4 * 33], s[5 * 33]); o.w = cvt_pk_bf16(s[6 * 33], s[7 * 33]);
            *(u32x4*)(WT + (size_t)(n0 + n) * Kd + k0 + 8 * c) = o; }
        asm volatile("s_waitcnt lgkmcnt(0)" ::: "memory");
    }
}

struct Args {
    const float* x; const int* pos; const float* norm_mix; const float* norm_ffn; const float* final_norm;
    const float* w_dkv; const float* q_norm; const float* kv_norm; const float* w_uq; const float* w_ukv; const float* w_o;
    const float* w_in; const float* ln_g; const float* ln_b; const float* w_sp; const float* b_sp; const float* w_out;
    const float* w_up; const float* w_down;
    float* out; unsigned char* ws;
};

__device__ __forceinline__ void conv_set_a(const Args& a, int j, LAS float* scr, int gw, int NGW, int lane) {
    const int L = 2 * j;
    unsigned char* wa = a.ws + WS_WA;
    { const float* W = a.w_dkv + (size_t)j * 1024 * 448; const float* g = a.norm_mix + L * 1024;
      auto f = [=](int k, int n) -> float { int c;
          if (n < 256) c = n; else { const int l = n - 256, h2 = l >> 7, ll = l & 127; c = ll < 64 ? 256 + h2 * 64 + ll : (ll < 96 ? 384 + h2 * 32 + (ll - 64) : -1); }
          return c < 0 ? 0.f : W[(size_t)k * 448 + c] * g[k]; };
      conv_matrix(f, (bf16_t*)(wa + WA_LAT), 1024, 512, scr, gw, NGW, lane); }
    { const float* Wq = a.w_uq + (size_t)j * 256 * 1536; const float* Wkv = a.w_ukv + (size_t)j * 128 * 2048; const float* gq = a.q_norm + j * 256; const float* gk = a.kv_norm + j * 128;
      auto f = [=](int k, int n) -> float {
          if (n < 1536) { if (k >= 256) return 0.f; int c;
              if (n < 1024) c = (n >> 7) * 192 + (n & 127); else { const int l = n - 1024, uu = l >> 8, ll = l & 255, half = ll >> 7, hh = (ll & 127) >> 5, jj = ll & 31; c = (uu * 4 + hh) * 192 + 128 + half * 32 + jj; }
              return Wq[(size_t)k * 1536 + c] * gq[k]; }
          if (k < 256) return 0.f; const int l = n - 1536; return Wkv[(size_t)(k - 256) * 2048 + (l >> 7) * 256 + (l & 127)] * gk[k - 256]; };
      conv_matrix(f, (bf16_t*)(wa + WA_QK), LATK, 2560, scr, gw, NGW, lane); }
    { const float* Wkv = a.w_ukv + (size_t)j * 128 * 2048; const float* gk = a.kv_norm + j * 128;
      auto f = [=](int k, int n) -> float { if (k < 256) return 0.f; return Wkv[(size_t)(k - 256) * 2048 + (n >> 7) * 256 + 128 + (n & 127)] * gk[k - 256]; };
      conv_matrix(f, (bf16_t*)(wa + WA_V), LATK, 1024, scr, gw, NGW, lane); }
    { const float* W = a.w_o + (size_t)j * 1024 * 1024;
      auto f = [=](int k, int n) -> float { return W[(size_t)k * 1024 + n]; };
      conv_matrix(f, (bf16_t*)(wa + WA_O), 1024, 1024, scr, gw, NGW, lane); }
    { const float* W = a.w_up + (size_t)L * 1024 * 4096; const float* g = a.norm_ffn + L * 1024;
      auto f = [=](int k, int n) -> float { return W[(size_t)k * 4096 + n] * g[k]; };
      conv_matrix(f, (bf16_t*)(wa + WA_UP), 1024, 4096, scr, gw, NGW, lane); }
    { const float* W = a.w_down + (size_t)L * 4096 * 1024;
      auto f = [=](int k, int n) -> float { return W[(size_t)k * 1024 + n]; };
      conv_matrix(f, (bf16_t*)(wa + WA_DN), 4096, 1024, scr, gw, NGW, lane); }
}
__device__ __forceinline__ void conv_set_b(const Args& a, int j, LAS float* scr, int gw, int NGW, int lane) {
    const int L = 2 * j + 1;
    unsigned char* wb = a.ws + WS_WB;
    { const float* W = a.w_in + (size_t)j * 1024 * 4096; const float* g = a.norm_mix + L * 1024;
      auto f = [=](int k, int n) -> float { return W[(size_t)k * 4096 + n] * g[k]; };
      conv_matrix(f, (bf16_t*)(wb + WB_INU), 1024, 2048, scr, gw, NGW, lane);
      auto f2 = [=](int k, int n) -> float { return W[(size_t)k * 4096 + 2048 + n] * g[k]; };
      conv_matrix(f2, (bf16_t*)(wb + WB_INV), 1024, 2048, scr, gw, NGW, lane); }
    { const float* W = a.w_out + (size_t)j * 2048 * 1024;
      auto f = [=](int k, int n) -> float { return W[(size_t)k * 1024 + n]; };
      conv_matrix(f, (bf16_t*)(wb + WB_OUT), 2048, 1024, scr, gw, NGW, lane); }
    { const float* W = a.w_up + (size_t)L * 1024 * 4096; const float* g = a.norm_ffn + L * 1024;
      auto f = [=](int k, int n) -> float { return W[(size_t)k * 4096 + n] * g[k]; };
      conv_matrix(f, (bf16_t*)(wb + WB_UP), 1024, 4096, scr, gw, NGW, lane); }
    { const float* W = a.w_down + (size_t)L * 4096 * 1024;
      auto f = [=](int k, int n) -> float { return W[(size_t)k * 1024 + n]; };
      conv_matrix(f, (bf16_t*)(wb + WB_DN), 4096, 1024, scr, gw, NGW, lane); }
}

__global__ void __launch_bounds__(512, 2) mega_fwd(Args a) {
    extern __shared__ __attribute__((aligned(16))) unsigned char lds_raw[];
    LAS unsigned char* lds = (LAS unsigned char*)lds_raw;
    cg::grid_group grid = cg::this_grid();
    const int tid = threadIdx.x, lane = tid & 63, wave = __builtin_amdgcn_readfirstlane(tid >> 6);
    const int G = gridDim.x, bx = blockIdx.x;
    const int gw = bx * 8 + wave, NGW = G * 8;
    unsigned char* ws = a.ws;
    float* ssqx = (float*)(ws + WS_SSQX); float* ssqq = (float*)(ws + WS_SSQQ); float* ssqkv = (float*)(ws + WS_SSQKV); float* lnst = (float*)(ws + WS_LNST);
    float* cst = (float*)(ws + WS_COS); float* snt = (float*)(ws + WS_SIN);
    bf16_t* KR = (bf16_t*)(ws + WS_KR); bf16_t* WSP = (bf16_t*)(ws + WS_WSP);
    bf16_t* XB = (bf16_t*)(ws + WS_XB);
    unsigned char* hb = ws + WS_HB; unsigned char* wa = ws + WS_WA; unsigned char* wb = ws + WS_WB;
    bf16_t* HB = (bf16_t*)hb;
    bf16_t* LAT = (bf16_t*)(hb + HB_LAT); bf16_t* QN = (bf16_t*)(hb + HB_QN); bf16_t* QR = (bf16_t*)(hb + HB_QR); bf16_t* KN = (bf16_t*)(hb + HB_KN); bf16_t* VT = (bf16_t*)(hb + HB_VT);
    bf16_t* UB = (bf16_t*)(hb + HB_U); bf16_t* VTS = (bf16_t*)(hb + HB_VTS);
    float* X32 = a.out;
    LAS float* scr = (LAS float*)(lds + wave * 16384);

    conv_set_a(a, 0, scr, gw, NGW, lane);
    conv_set_b(a, 0, scr, gw, NGW, lane);
    for (int i = gw * 64 + lane; i < 2 * 8 * 128 * 128; i += NGW * 64) { const int s = i & 127, t = (i >> 7) & 127; WSP[i] = (bf16_t)(cvt_pk_bf16(s <= t ? a.w_sp[i] : 0.f, 0.f) & 0xffffu); }
    for (int i = gw * 64 + lane; i < M * 32; i += NGW * 64) { const int tok = i >> 5, fi = i & 31;
        const float inv_freq = exp2f(-(float)(2 * fi) * (13.287712379549449f / 64.0f));
        const float ang = (float)a.pos[tok] * inv_freq;
        const double rev = (double)ang * 0.15915494309189535; const float fr = (float)(rev - __builtin_rint(rev));
        cst[i] = __builtin_amdgcn_cosf(fr); snt[i] = __builtin_amdgcn_sinf(fr); }
    for (int m = gw; m < M; m += NGW) {
        const f32x4* xr = (const f32x4*)(a.x + (size_t)m * DM) + lane;
#pragma unroll
        for (int jj = 0; jj < 4; ++jj) { const f32x4 v = xr[64 * jj]; float s = dot4(v);
            u32x2 w; w.x = cvt_pk_bf16(v[0], v[1]); w.y = cvt_pk_bf16(v[2], v[3]);
            *(u32x2*)(XB + (size_t)m * DM + 256 * jj + 4 * lane) = w;
            s += __shfl_xor(s, 1); s += __shfl_xor(s, 2); s += __shfl_xor(s, 4); s += __shfl_xor(s, 8);
            if ((lane & 15) == 0) ssqx[(size_t)m * 16 + 4 * jj + (lane >> 4)] = s; }
    }
    grid.sync();

    for (int L = 0; L < 4; ++L) {
        const int j = L >> 1;
        if ((L & 1) == 0) {
            { pg8::Gemm g{XB, (const bf16_t*)(wa + WA_LAT), M, 512, 1024, 1024, 1024}; pg8::StaticOrder S; S.init(M, 512, G, bx);
              EpiLat E{LAT, KR, ssqx, ssqq, ssqkv, cst, snt};
              pg8::gemm_phase(lds, g, S, E); }
            grid.sync();
            { pg8::Gemm g{LAT, (const bf16_t*)(wa + WA_QK), M, 2560, LATK, LATK, LATK}; pg8::StaticOrder S; S.init(M, 2560, G, bx);
              EpiQK E{QN, QR, KN, ssqq, ssqkv, cst, snt};
              pg8::gemm_phase(lds, g, S, E); }
            { pg8::Gemm g{(const bf16_t*)(wa + WA_V), LAT, 1024, M, LATK, LATK, LATK}; pg8::StaticOrder S; S.init(1024, M, G, bx);
              EpiVT E{VT, ssqkv};
              pg8::gemm_phase(lds, g, S, E); }
            grid.sync();
            { const int nsl = (G == 256) ? 1 : 0;
              for (int p0 = bx; p0 < 256; p0 += G) {
                  const int p = nsl ? ((p0 & 7) * 32 + (p0 >> 3)) : p0;
                  const int bh = p >> 3, pi = p & 7;
                  att::attn_unit(lds, bh >> 3, bh & 7, 15 - pi, QN, QR, KN, KR, VT, QN);
                  att::attn_unit(lds, bh >> 3, bh & 7, pi, QN, QR, KN, KR, VT, QN);
              }
              __syncthreads(); }
            if (L == 2) conv_set_b(a, 1, scr, gw, NGW, lane);
            grid.sync();
            { pg8::Gemm g{QN, (const bf16_t*)(wa + WA_O), M, 1024, 1024, 1024, 1024}; pg8::StaticOrder S; S.init(M, 1024, G, bx);
              EpiRes E{L == 0 ? a.x : X32, X32, XB, ssqx};
              pg8::gemm_phase(lds, g, S, E); }
            grid.sync();
        } else {
            { pg8::Gemm g{XB, (const bf16_t*)(wb + WB_INU), M, SGW, 1024, 1024, 1024}; pg8::StaticOrder S; S.init(M, SGW, G, bx);
              EpiU E{UB, ssqx};
              pg8::gemm_phase(lds, g, S, E); }
            { pg8::Gemm g{(const bf16_t*)(wb + WB_INV), XB, SGW, M, 1024, 1024, 1024}; pg8::StaticOrder S; S.init(SGW, M, G, bx);
              EpiVTS E{VTS, ssqx, lnst};
              pg8::gemm_phase(lds, g, S, E); }
            grid.sync();
            { const bf16_t* wsp = WSP + (size_t)j * 8 * 128 * 128; const float* bsp = a.b_sp + j * 8 * 128;
              for (int it = bx; it < 1024; it += G) sgu::item(lds, it >> 3, it & 7, VTS, lnst, a.ln_g + j * SGW, a.ln_b + j * SGW, wsp, bsp, UB); }
            if (L == 1) conv_set_a(a, 1, scr, gw, NGW, lane);
            grid.sync();
            { pg8::Gemm g{UB, (const bf16_t*)(wb + WB_OUT), M, 1024, SGW, SGW, SGW}; pg8::StaticOrder S; S.init(M, 1024, G, bx);
              EpiRes E{X32, X32, XB, ssqx};
              pg8::gemm_phase(lds, g, S, E); }
            grid.sync();
        }
        unsigned char* wl = (L & 1) ? wb : wa;
        const size_t off_up = (L & 1) ? WB_UP : WA_UP, off_dn = (L & 1) ? WB_DN : WA_DN;
        { pg8::Gemm g{XB, (const bf16_t*)(wl + off_up), M, FF, 1024, 1024, 1024}; pg8::StaticOrder S; S.init(M, FF, G, bx);
          EpiUp E{HB, ssqx};
          pg8::gemm_phase(lds, g, S, E); }
        grid.sync();
        { pg8::Gemm g{HB, (const bf16_t*)(wl + off_dn), M, 1024, FF, FF, FF}; pg8::StaticOrder S; S.init(M, 1024, G, bx);
          EpiRes E{X32, X32, XB, ssqx};
          pg8::gemm_phase(lds, g, S, E); }
        grid.sync();
    }
    int lt2_ = threadIdx.x; asm volatile("" : "+v"(lt2_)); const int lane2 = lt2_ & 63;
    for (int m = gw; m < M; m += NGW) {
        f32x4* xr = (f32x4*)(X32 + (size_t)m * DM) + lane2; const f32x4* gr = (const f32x4*)a.final_norm + lane2;
        f32x4 v[4]; float s = 0.f;
#pragma unroll
        for (int jj = 0; jj < 4; ++jj) { v[jj] = xr[64 * jj]; s += dot4(v[jj]); }
        const float r = 1.0f / sqrtf(wave_sum(s) * (1.0f / 1024.0f) + NORM_EPS);
#pragma unroll
        for (int jj = 0; jj < 4; ++jj) xr[64 * jj] = v[jj] * r * gr[64 * jj];
    }
}

extern "C" void kernel_launch(void* const* d_in, const int* in_sizes, int n_in, void* d_out, int out_size, void* d_ws, size_t ws_size, hipStream_t stream) {
    static int grid = 0;
    if (grid == 0) {
        if (n_in != 19 || out_size != M * DM || ws_size < WS_END) { fprintf(stderr, "kernel_launch: unexpected shapes (n_in %d out %d ws %zu)\n", n_in, out_size, ws_size); grid = -1; return; }
        int dev = 0, cus = 0, per_cu = 0;
        hipGetDevice(&dev); hipDeviceGetAttribute(&cus, hipDeviceAttributeMultiprocessorCount, dev);
        hipFuncSetAttribute((const void*)mega_fwd, hipFuncAttributeMaxDynamicSharedMemorySize, LDS_BYTES);
        hipOccupancyMaxActiveBlocksPerMultiprocessor(&per_cu, (const void*)mega_fwd, 512, LDS_BYTES);
        if (per_cu < 1) { fprintf(stderr, "kernel_launch: occupancy query returned %d\n", per_cu); per_cu = 1; }
        grid = cus * per_cu;
    }
    if (grid < 0) return;
    Args a{};
    a.x = (const float*)d_in[0]; a.pos = (const int*)d_in[1]; a.norm_mix = (const float*)d_in[2]; a.norm_ffn = (const float*)d_in[3]; a.final_norm = (const float*)d_in[4];
    a.w_dkv = (const float*)d_in[5]; a.q_norm = (const float*)d_in[6]; a.kv_norm = (const float*)d_in[7]; a.w_uq = (const float*)d_in[8]; a.w_ukv = (const float*)d_in[9]; a.w_o = (const float*)d_in[10];
    a.w_in = (const float*)d_in[11]; a.ln_g = (const float*)d_in[12]; a.ln_b = (const float*)d_in[13]; a.w_sp = (const float*)d_in[14]; a.b_sp = (const float*)d_in[15]; a.w_out = (const float*)d_in[16];
    a.w_up = (const float*)d_in[17]; a.w_down = (const float*)d_in[18];
    a.out = (float*)d_out; a.ws = (unsigned char*)d_ws;
    void* args[] = {&a};
    hipError_t e = hipLaunchCooperativeKernel((const void*)mega_fwd, dim3(grid), dim3(512), args, LDS_BYTES, stream);
    if (e != hipSuccess) fprintf(stderr, "cooperative launch failed: %s (grid %d)\n", hipGetErrorString(e), grid);
}
```

```cpp
#include <hip/hip_runtime.h>
#include <hip/hip_cooperative_groups.h>
#include <cstdio>
#include <cstdint>
namespace cg = cooperative_groups;

#define LAS __attribute__((address_space(3)))
typedef unsigned short bf16_t;
typedef short bf16x8 __attribute__((ext_vector_type(8)));
typedef float f32x4 __attribute__((ext_vector_type(4)));
typedef float f32x2 __attribute__((ext_vector_type(2)));
typedef float f32x16 __attribute__((ext_vector_type(16)));
typedef unsigned u32x4 __attribute__((ext_vector_type(4)));
typedef unsigned u32x2 __attribute__((ext_vector_type(2)));

constexpr int M = 16384, DM = 1024, SEQ = 4096, NH = 8, FF = 4096, SGW = 2048;
constexpr int LATK = 384;
constexpr float NORM_EPS = 1e-6f, LN_EPS = 1e-5f;
constexpr float QSCALE = 0.07216878364870322f * 1.4426950408889634f;

constexpr size_t MiB = 1u << 20;
constexpr size_t WS_SSQX = 0;
constexpr size_t WS_SSQQ = 1 * MiB;
constexpr size_t WS_SSQKV = 1 * MiB + 256 * 1024;
constexpr size_t WS_LNST = 2 * MiB;
constexpr size_t WS_COS = 4 * MiB, WS_SIN = 6 * MiB;
constexpr size_t WS_KR = 8 * MiB;
constexpr size_t WS_WSP = 10 * MiB;
constexpr size_t WS_CTL = 12 * MiB;
constexpr size_t WS_WA = 16 * MiB;
constexpr size_t WA_LAT = 0, WA_QK = 1 * MiB, WA_V = 3 * MiB, WA_O = 4 * MiB, WA_UP = 6 * MiB, WA_DN = 14 * MiB;
constexpr size_t WS_WB = 40 * MiB;
constexpr size_t WB_INU = 0, WB_INV = 4 * MiB, WB_OUT = 8 * MiB, WB_UP = 12 * MiB, WB_DN = 20 * MiB;
constexpr size_t WS_XB = 72 * MiB;
constexpr size_t WS_HB = 104 * MiB;
constexpr size_t HB_LAT = 0, HB_QN = 16 * MiB, HB_QR = 48 * MiB, HB_KN = 64 * MiB, HB_VT = 96 * MiB;
constexpr size_t HB_U = 0, HB_VTS = 64 * MiB;
constexpr size_t WS_END = 232 * MiB;

constexpr int LDS_BYTES = 147456;

__device__ __forceinline__ unsigned cvt_pk_bf16(float lo, float hi) { unsigned r; asm volatile("v_cvt_pk_bf16_f32 %0, %1, %2" : "=v"(r) : "v"(lo), "v"(hi)); return r; }
__device__ __forceinline__ float bf2f(unsigned short b) { return __builtin_bit_cast(float, (unsigned)b << 16); }
__device__ __forceinline__ u32x4 pack8(f32x4 a, f32x4 b) { u32x4 w; w.x = cvt_pk_bf16(a[0], a[1]); w.y = cvt_pk_bf16(a[2], a[3]); w.z = cvt_pk_bf16(b[0], b[1]); w.w = cvt_pk_bf16(b[2], b[3]); return w; }
__device__ __forceinline__ float sum4(f32x4 v) { return (v[0] + v[1]) + (v[2] + v[3]); }
__device__ __forceinline__ float dot4(f32x4 v) { return (v[0] * v[0] + v[1] * v[1]) + (v[2] * v[2] + v[3] * v[3]); }
__device__ __forceinline__ f32x2 gelu_pk(f32x2 v) {
    const f32x2 av = __builtin_elementwise_abs(v), d = av * 0.2316418882f + 1.0f;
    f32x2 t; t.x = __builtin_amdgcn_rcpf(d.x); t.y = __builtin_amdgcn_rcpf(d.y);
    f32x2 q = t * 0.5307027145f + (-0.7265760135f); q = q * t + 0.7107068705f; q = q * t + (-0.142248368f); q = q * t + 0.127414796f; q = q * t;
    const f32x2 s = (v * v) * (-0.72134752044f);
    f32x2 e; e.x = __builtin_amdgcn_exp2f(s.x); e.y = __builtin_amdgcn_exp2f(s.y);
    const f32x2 m = v * (q * e), r = v - m;
    f32x2 o; o.x = v.x < 0.f ? m.x : r.x; o.y = v.y < 0.f ? m.y : r.y; return o;
}
__device__ __forceinline__ f32x4 gelu4(f32x4 v) { f32x2 a = gelu_pk((f32x2){v[0], v[1]}), b = gelu_pk((f32x2){v[2], v[3]}); return (f32x4){a.x, a.y, b.x, b.y}; }

namespace pg8 {
constexpr int BM = 256, BK = 64, HALF = 128, HTB = HALF * BK * 2, STAGE_BYTES = 8 * HTB, NXCD = 8, WGM = 8;
__device__ __forceinline__ int lds_byte(int r, int c) { const int st = (r >> 4) * 2 + (c >> 5), rr = r & 15, cc = c & 31, ob = rr * 64 + cc * 2; return st * 1024 + (ob ^ (((ob >> 9) & 1) << 5)); }
__device__ __forceinline__ void stage_rc(int b, int& R, int& C) { const int st = b / 1024, sb = b % 1024, swz = sb ^ (((sb >> 9) & 1) << 5); R = (st >> 1) * 16 + swz / 64; C = (st & 1) * 32 + (swz % 64) / 2; }
__device__ __forceinline__ int perm32(int rho) { const int n = rho >> 4, i = rho & 15; return 8 * (i >> 2) + 4 * n + (i & 3); }

struct Unit { int pm, pn; };
struct Gemm { const bf16_t* A; const bf16_t* Bt; int M, N, K, lda, ldb; };

struct StaticOrder {
    int nM, nN, nwg, G, c;
    __device__ void init(int M_, int N_, int G_, int c_) { asm volatile("" : "+s"(G_), "+s"(c_)); nM = M_ / BM; nN = N_ / BM; nwg = nM * nN; G = G_; c = c_; }
    __device__ bool next(int i, Unit& u) const {
        const long L = (long)i * G + c; if (L >= nwg) return false;
        int wgid = (int)L; { const int q = nwg / NXCD, r = nwg % NXCD, xcd = wgid % NXCD, off = wgid / NXCD; wgid = (xcd < r ? xcd * (q + 1) : r * (q + 1) + (xcd - r) * q) + off; }
        const int nig = WGM * nN, gid = wgid / nig, fm = gid * WGM, gsz = (nM - fm) < WGM ? (nM - fm) : WGM;
        u.pm = fm + ((wgid % nig) % gsz); u.pn = (wgid % nig) / gsz; return true;
    }
};

template <class Epi, class Sched>
__device__ __forceinline__ void gemm_phase(LAS unsigned char* lds, const Gemm g, const Sched& S, const Epi& E) {
    int tid_ = threadIdx.x; asm volatile("" : "+v"(tid_));
    const int tid = tid_, wid = __builtin_amdgcn_readfirstlane(tid >> 6), lane = tid & 63, wr = wid >> 2, wc = wid & 3, fr = lane & 15, fq = lane >> 4;
    int nt_ = g.K / BK; asm volatile("" : "+s"(nt_)); const int nt = nt_;
    unsigned voffA[2], voffB[2];
#pragma unroll
    for (int i = 0; i < 2; ++i) { int R, C; stage_rc(tid * 16 + i * 8192, R, C); const int Rb = (R & ~31) + perm32(R & 31);
        voffA[i] = (unsigned)(R * g.lda + C) * 2u; voffB[i] = (unsigned)(Rb * g.ldb + C) * 2u; }
    const size_t kstep = (size_t)(BK * 2);
    const size_t hA = (size_t)HALF * g.lda * 2, hB = (size_t)HALF * g.ldb * 2, tA = 2 * hA, tB = 2 * hB;
    const unsigned ldsw = (unsigned)wid * 1024u;
    const int aoff = lds_byte(wr * 64 + fr, fq * 8), boff = lds_byte(wc * 32 + fr, fq * 8);
#define PG8_SA(b, h) (((b) * 2 + (h)) * HTB)
#define PG8_SB(b, h) ((4 + (b) * 2 + (h)) * HTB)
#define PG8_STAGE(bufoff, gbase, voff) do { _Pragma("unroll") for (int _i = 0; _i < 2; ++_i) \
        __builtin_amdgcn_global_load_lds((const unsigned*)((const char*)(gbase) + (voff)[_i]), (LAS unsigned*)(lds + (bufoff) + ldsw + _i * 8192), 16, 0, 0); } while (0)
#define PG8_LDA(dst, b, h) do { _Pragma("unroll") for (int m = 0; m < 4; ++m) _Pragma("unroll") for (int k = 0; k < 2; ++k) dst[m][k] = *(const LAS bf16x8*)(lds + PG8_SA(b, h) + aoff + m * 2048 + k * 1024); } while (0)
#define PG8_LDB(dst, b, h) do { _Pragma("unroll") for (int n = 0; n < 2; ++n) _Pragma("unroll") for (int k = 0; k < 2; ++k) dst[n][k] = *(const LAS bf16x8*)(lds + PG8_SB(b, h) + boff + n * 2048 + k * 1024); } while (0)
#define PG8_MMA(ai, bj, At, Bt) do { __builtin_amdgcn_s_setprio(1); _Pragma("unroll") for (int m = 0; m < 4; ++m) _Pragma("unroll") for (int n = 0; n < 2; ++n) _Pragma("unroll") for (int k = 0; k < 2; ++k) \
        acc[ai][bj][m][n] = __builtin_amdgcn_mfma_f32_16x16x32_bf16(Bt[n][k], At[m][k], acc[ai][bj][m][n], 0, 0, 0); __builtin_amdgcn_s_setprio(0); } while (0)
#define PG8_WAIT_V(n) asm volatile("s_waitcnt vmcnt(" #n ")" ::: "memory")
#define PG8_WAIT_L(n) asm volatile("s_waitcnt lgkmcnt(" #n ")" ::: "memory")
#define PG8_BAR __builtin_amdgcn_s_barrier()
#define PG8_SCHED __builtin_amdgcn_sched_barrier(0)
    Unit cur, nxt; int ui = 0;
    if (!S.next(0, cur)) return;
    f32x4 acc[2][2][4][2];
#pragma unroll
    for (int a = 0; a < 2; ++a)
#pragma unroll
        for (int b = 0; b < 2; ++b)
#pragma unroll
            for (int m = 0; m < 4; ++m)
#pragma unroll
                for (int n = 0; n < 2; ++n) acc[a][b][m][n] = (f32x4){0.f, 0.f, 0.f, 0.f};
    bf16x8 At[4][2], B0[2][2], B1[2][2];
    const char* cA = (const char*)g.A + (size_t)cur.pm * tA; const char* cB = (const char*)g.Bt + (size_t)cur.pn * tB;
    PG8_STAGE(PG8_SB(0, 0), cB, voffB); PG8_STAGE(PG8_SB(0, 1), cB + hB, voffB); PG8_STAGE(PG8_SA(0, 0), cA, voffA); PG8_STAGE(PG8_SA(0, 1), cA + hA, voffA);
    if (wr == 1) PG8_BAR;
    PG8_WAIT_V(2); PG8_BAR;
    PG8_STAGE(PG8_SB(1, 0), cB + kstep, voffB); PG8_STAGE(PG8_SA(1, 0), cA + kstep, voffA); PG8_STAGE(PG8_SB(1, 1), cB + hB + kstep, voffB);
    PG8_WAIT_V(6); PG8_BAR;
    for (;;) {
        const bool has_next = S.next(ui + 1, nxt);
        const char* nA = has_next ? (const char*)g.A + (size_t)nxt.pm * tA : cA; const char* nB = has_next ? (const char*)g.Bt + (size_t)nxt.pn * tB : cB;
#pragma unroll 1
        for (int t = 0; t < nt; t += 2) {
            const bool last = (t == nt - 2);
            const char* a1 = cA + (size_t)(t + 1) * kstep;
            const char* a2 = last ? nA : cA + (size_t)(t + 2) * kstep; const char* b2 = last ? nB : cB + (size_t)(t + 2) * kstep;
            const char* a3 = a2 + kstep; const char* b3 = b2 + kstep;
            PG8_LDB(B0, 0, 0); PG8_LDB(B1, 0, 1); PG8_SCHED; PG8_LDA(At, 0, 0); PG8_STAGE(PG8_SA(1, 1), a1 + hA, voffA);
            PG8_WAIT_V(8); PG8_WAIT_L(0); PG8_BAR; PG8_MMA(0, 0, At, B0); PG8_MMA(0, 1, At, B1); PG8_BAR; PG8_SCHED;
            PG8_LDA(At, 0, 1); PG8_STAGE(PG8_SB(0, 0), b2, voffB); PG8_STAGE(PG8_SB(0, 1), b2 + hB, voffB); PG8_STAGE(PG8_SA(0, 0), a2, voffA);
            PG8_WAIT_V(8); PG8_WAIT_L(0); PG8_BAR; PG8_MMA(1, 0, At, B0); PG8_MMA(1, 1, At, B1); PG8_BAR; PG8_SCHED;
            PG8_LDB(B0, 1, 0); PG8_LDB(B1, 1, 1); PG8_SCHED; PG8_LDA(At, 1, 0); PG8_STAGE(PG8_SA(0, 1), a2 + hA, voffA);
            PG8_WAIT_V(8); PG8_WAIT_L(0); PG8_BAR; PG8_MMA(0, 0, At, B0); PG8_MMA(0, 1, At, B1); PG8_BAR; PG8_SCHED;
            PG8_LDA(At, 1, 1); PG8_STAGE(PG8_SB(1, 0), b3, voffB); PG8_STAGE(PG8_SB(1, 1), b3 + hB, voffB); PG8_STAGE(PG8_SA(1, 0), a3, voffA);
            PG8_WAIT_V(8); PG8_WAIT_L(0); PG8_BAR; PG8_MMA(1, 0, At, B0); PG8_MMA(1, 1, At, B1); PG8_BAR; PG8_SCHED;
        }
        if (wr == 0) PG8_BAR;
        E(acc, cur, wr, wc, fr, fq);
        if (!has_next) break;
#pragma unroll
        for (int a = 0; a < 2; ++a)
#pragma unroll
            for (int b = 0; b < 2; ++b)
#pragma unroll
                for (int m = 0; m < 4; ++m)
#pragma unroll
                    for (int n = 0; n < 2; ++n) acc[a][b][m][n] = (f32x4){0.f, 0.f, 0.f, 0.f};
        cur = nxt; cA = nA; cB = nB; ++ui;
        if (wr == 1) PG8_BAR;
    }
    PG8_WAIT_V(0);
    PG8_BAR;
#undef PG8_SA
#undef PG8_SB
#undef PG8_STAGE
#undef PG8_LDA
#undef PG8_LDB
#undef PG8_MMA
#undef PG8_WAIT_V
#undef PG8_WAIT_L
#undef PG8_BAR
#undef PG8_SCHED
}
}

typedef f32x4 Acc[2][2][4][2];

__device__ __forceinline__ float row_rx(const float* ssq, int row, int fq) {
    float s = sum4(*(const f32x4*)(ssq + (size_t)row * 16 + 4 * fq));
    s += __shfl_xor(s, 16); s += __shfl_xor(s, 32);
    return 1.0f / sqrtf(s * (1.0f / 1024.0f) + NORM_EPS);
}

struct EpiUp {
    bf16_t* O; const float* ssq;
    __device__ __forceinline__ void operator()(const Acc& acc, const pg8::Unit& u, int wr, int wc, int fr, int fq) const {
        const int row0 = u.pm * 256 + wr * 64 + fr, col0 = u.pn * 256 + wc * 32 + 8 * fq;
#pragma unroll
        for (int ai = 0; ai < 2; ++ai)
#pragma unroll
            for (int m = 0; m < 4; ++m) { const int row = row0 + ai * 128 + m * 16; const float r = row_rx(ssq, row, fq);
#pragma unroll
                for (int bj = 0; bj < 2; ++bj) { f32x4 v0 = acc[ai][bj][m][0] * r, v1 = acc[ai][bj][m][1] * r;
                    v0 = __builtin_elementwise_max(v0, (f32x4){0.f, 0.f, 0.f, 0.f}); v1 = __builtin_elementwise_max(v1, (f32x4){0.f, 0.f, 0.f, 0.f});
                    *(u32x4*)(O + (size_t)row * FF + col0 + bj * 128) = pack8(v0 * v0, v1 * v1); } asm volatile("" ::: "memory"); }
    }
};
struct EpiU {
    bf16_t* O; const float* ssq;
    __device__ __forceinline__ void operator()(const Acc& acc, const pg8::Unit& u, int wr, int wc, int fr, int fq) const {
        const int row0 = u.pm * 256 + wr * 64 + fr, col0 = u.pn * 256 + wc * 32 + 8 * fq;
#pragma unroll
        for (int ai = 0; ai < 2; ++ai)
#pragma unroll
            for (int m = 0; m < 4; ++m) { const int row = row0 + ai * 128 + m * 16; const float r = row_rx(ssq, row, fq);
#pragma unroll
                for (int bj = 0; bj < 2; ++bj) { const f32x4 v0 = gelu4(acc[ai][bj][m][0] * r), v1 = gelu4(acc[ai][bj][m][1] * r);
                    *(u32x4*)(O + (size_t)row * SGW + col0 + bj * 128) = pack8(v0, v1); } asm volatile("" ::: "memory"); }
    }
};
struct EpiRes {
    const float* xin; float* xout; bf16_t* xb; float* ssq;
    __device__ __forceinline__ void operator()(const Acc& acc, const pg8::Unit& u, int wr, int wc, int fr, int fq) const {
        const int row0 = u.pm * 256 + wr * 64 + fr, col0 = u.pn * 256 + wc * 32 + 8 * fq;
#pragma unroll
        for (int ai = 0; ai < 2; ++ai)
#pragma unroll
            for (int m = 0; m < 4; ++m) { const int row = row0 + ai * 128 + m * 16; float s = 0.f;
#pragma unroll
                for (int bj = 0; bj < 2; ++bj) { const size_t p = (size_t)row * DM + col0 + bj * 128;
                    const f32x4 x0 = *(const f32x4*)(xin + p) + acc[ai][bj][m][0], x1 = *(const f32x4*)(xin + p + 4) + acc[ai][bj][m][1];
                    *(f32x4*)(xout + p) = x0; *(f32x4*)(xout + p + 4) = x1; *(u32x4*)(xb + p) = pack8(x0, x1); s += dot4(x0) + dot4(x1); }
                s += __shfl_xor(s, 16); s += __shfl_xor(s, 32);
                if (fq == 0) ssq[(size_t)row * 16 + u.pn * 4 + wc] = s; asm volatile("" ::: "memory"); }
    }
};
struct EpiLat {
    bf16_t* lat; bf16_t* kr; const float* ssqx; float* ssqq; float* ssqkv; const float* cs; const float* sn;
    __device__ __forceinline__ void operator()(const Acc& acc, const pg8::Unit& u, int wr, int wc, int fr, int fq) const {
        const int row0 = u.pm * 256 + wr * 64 + fr;
#pragma unroll
        for (int ai = 0; ai < 2; ++ai)
#pragma unroll
            for (int m = 0; m < 4; ++m) { const int row = row0 + ai * 128 + m * 16; const float r = row_rx(ssqx, row, fq);
                const f32x4 a0 = acc[ai][0][m][0] * r, a1 = acc[ai][0][m][1] * r, b0 = acc[ai][1][m][0] * r, b1 = acc[ai][1][m][1] * r;
                if (u.pn == 0) {
                    bf16_t* o = lat + (size_t)row * LATK + wc * 32 + 8 * fq;
                    *(u32x4*)o = pack8(a0, a1); *(u32x4*)(o + 128) = pack8(b0, b1);
                    float s = dot4(a0) + dot4(a1) + dot4(b0) + dot4(b1); s += __shfl_xor(s, 16); s += __shfl_xor(s, 32);
                    if (fq == 0) ssqq[(size_t)row * 4 + wc] = s;
                } else if (wc < 2) {
                    bf16_t* o = lat + (size_t)row * LATK + 256 + wc * 32 + 8 * fq;
                    *(u32x4*)o = pack8(a0, a1); *(u32x4*)(o + 64) = pack8(b0, b1);
                    float s = dot4(a0) + dot4(a1) + dot4(b0) + dot4(b1); s += __shfl_xor(s, 16); s += __shfl_xor(s, 32);
                    if (fq == 0) { ssqkv[(size_t)row * 4 + wc] = s; ssqkv[(size_t)row * 4 + 2 + wc] = 0.f; }
                } else if (wc == 2) {
                    const float* cp = cs + (size_t)row * 32 + 8 * fq; const float* sp = sn + (size_t)row * 32 + 8 * fq;
                    const f32x4 c0 = *(const f32x4*)cp, c1 = *(const f32x4*)(cp + 4), s0 = *(const f32x4*)sp, s1 = *(const f32x4*)(sp + 4);
                    bf16_t* o = kr + (size_t)row * 64 + 8 * fq;
                    *(u32x4*)o = pack8(a0 * c0 - b0 * s0, a1 * c1 - b1 * s1);
                    *(u32x4*)(o + 32) = pack8(b0 * c0 + a0 * s0, b1 * c1 + a1 * s1);
                }
                asm volatile("" ::: "memory");
            }
    }
};
struct EpiQK {
    bf16_t* qn; bf16_t* qr; bf16_t* kn; const float* ssqq; const float* ssqkv; const float* cs; const float* sn;
    __device__ __forceinline__ void operator()(const Acc& acc, const pg8::Unit& u, int wr, int wc, int fr, int fq) const {
        const int row0 = u.pm * 256 + wr * 64 + fr;
#pragma unroll
        for (int ai = 0; ai < 2; ++ai)
#pragma unroll
            for (int m = 0; m < 4; ++m) { const int row = row0 + ai * 128 + m * 16;
                const bool isq = u.pn < 6;
                const float ss = sum4(*(const f32x4*)((isq ? ssqq : ssqkv) + (size_t)row * 4));
                const float r = (isq ? QSCALE : 1.0f) / sqrtf(ss * (isq ? (1.0f / 256.0f) : (1.0f / 128.0f)) + NORM_EPS);
                const f32x4 a0 = acc[ai][0][m][0] * r, a1 = acc[ai][0][m][1] * r, b0 = acc[ai][1][m][0] * r, b1 = acc[ai][1][m][1] * r;
                if (u.pn < 4) {
                    bf16_t* o = qn + (size_t)row * 1024 + u.pn * 256 + wc * 32 + 8 * fq;
                    *(u32x4*)o = pack8(a0, a1); *(u32x4*)(o + 128) = pack8(b0, b1);
                } else if (u.pn < 6) {
                    const float* cp = cs + (size_t)row * 32 + 8 * fq; const float* sp = sn + (size_t)row * 32 + 8 * fq;
                    const f32x4 c0 = *(const f32x4*)cp, c1 = *(const f32x4*)(cp + 4), s0 = *(const f32x4*)sp, s1 = *(const f32x4*)(sp + 4);
                    bf16_t* o = qr + (size_t)row * 512 + ((u.pn - 4) * 4 + wc) * 64 + 8 * fq;
                    *(u32x4*)o = pack8(a0 * c0 - b0 * s0, a1 * c1 - b1 * s1);
                    *(u32x4*)(o + 32) = pack8(b0 * c0 + a0 * s0, b1 * c1 + a1 * s1);
                } else {
                    bf16_t* o = kn + (size_t)row * 1024 + (u.pn - 6) * 256 + wc * 32 + 8 * fq;
                    *(u32x4*)o = pack8(a0, a1); *(u32x4*)(o + 128) = pack8(b0, b1);
                }
                asm volatile("" ::: "memory");
            }
    }
};
struct EpiVT {
    bf16_t* vt; const float* ssqkv;
    __device__ __forceinline__ void operator()(const Acc& acc, const pg8::Unit& u, int wr, int wc, int fr, int fq) const {
        const int lane = threadIdx.x & 63;
        const int tokb = u.pn * 256 + wc * 32 + 8 * fq;
        float rmine; { const int tok = tokb + (fr >> 3) * 128 + (fr & 7); rmine = 1.0f / sqrtf(sum4(*(const f32x4*)(ssqkv + (size_t)tok * 4)) * (1.0f / 128.0f) + NORM_EPS); }
        const int f0 = u.pm * 256 + wr * 64 + fr;
#pragma unroll
        for (int bj = 0; bj < 2; ++bj) {
            f32x4 r0, r1;
#pragma unroll
            for (int e = 0; e < 4; ++e) { r0[e] = __shfl(rmine, (lane & 48) | (bj * 8 + e)); r1[e] = __shfl(rmine, (lane & 48) | (bj * 8 + 4 + e)); }
            const int g16 = u.pn * 256 + bj * 128 + wc * 32 + (fq >> 1) * 16;
#pragma unroll
            for (int ai = 0; ai < 2; ++ai)
#pragma unroll
                for (int m = 0; m < 4; ++m) { const int f = f0 + ai * 128 + m * 16;
                    const f32x4 v0 = acc[ai][bj][m][0] * r0, v1 = acc[ai][bj][m][1] * r1;
                    bf16_t* o = vt + (size_t)f * M + g16 + 4 * (fq & 1);
                    u32x2 w0, w1; w0.x = cvt_pk_bf16(v0[0], v0[1]); w0.y = cvt_pk_bf16(v0[2], v0[3]); w1.x = cvt_pk_bf16(v1[0], v1[1]); w1.y = cvt_pk_bf16(v1[2], v1[3]);
                    *(u32x2*)o = w0; *(u32x2*)(o + 8) = w1; asm volatile("" ::: "memory"); }
        }
    }
};
struct EpiVTS {
    bf16_t* vt; const float* ssqx; float* lnst;
    __device__ __forceinline__ void operator()(const Acc& acc, const pg8::Unit& u, int wr, int wc, int fr, int fq) const {
        const int lane = threadIdx.x & 63;
        const int tokb = u.pn * 256 + wc * 32 + 8 * fq;
        float rmine; { const int tok = tokb + (fr >> 3) * 128 + (fr & 7); const float* p = ssqx + (size_t)tok * 16;
            const float s = (sum4(*(const f32x4*)p) + sum4(*(const f32x4*)(p + 4))) + (sum4(*(const f32x4*)(p + 8)) + sum4(*(const f32x4*)(p + 12)));
            rmine = 1.0f / sqrtf(s * (1.0f / 1024.0f) + NORM_EPS); }
        const int f0 = u.pm * 256 + wr * 64 + fr;
#pragma unroll
        for (int bj = 0; bj < 2; ++bj) {
            f32x4 r0, r1;
#pragma unroll
            for (int e = 0; e < 4; ++e) { r0[e] = __shfl(rmine, (lane & 48) | (bj * 8 + e)); r1[e] = __shfl(rmine, (lane & 48) | (bj * 8 + 4 + e)); }
            f32x4 s10 = {0.f, 0.f, 0.f, 0.f}, s11 = s10, s20 = s10, s21 = s10;
            const int tok0 = tokb + bj * 128;
#pragma unroll
            for (int ai = 0; ai < 2; ++ai)
#pragma unroll
                for (int m = 0; m < 4; ++m) { const int f = f0 + ai * 128 + m * 16;
                    const f32x4 v0 = gelu4(acc[ai][bj][m][0] * r0), v1 = gelu4(acc[ai][bj][m][1] * r1);
                    *(u32x4*)(vt + (size_t)f * M + tok0) = pack8(v0, v1);
                    s10 += v0; s11 += v1; s20 += v0 * v0; s21 += v1 * v1; asm volatile("" ::: "memory"); }
#pragma unroll
            for (int o = 1; o < 16; o <<= 1) {
#pragma unroll
                for (int e = 0; e < 4; ++e) { s10[e] += __shfl_xor(s10[e], o); s11[e] += __shfl_xor(s11[e], o); s20[e] += __shfl_xor(s20[e], o); s21[e] += __shfl_xor(s21[e], o); } }
            if (fr == 0) {
                const int slot = u.pm * 2 + wr;
#pragma unroll
                for (int e = 0; e < 4; ++e) {
                    *(f32x2*)(lnst + ((size_t)(tok0 + e) * 16 + slot) * 2) = (f32x2){s10[e], s20[e]};
                    *(f32x2*)(lnst + ((size_t)(tok0 + 4 + e) * 16 + slot) * 2) = (f32x2){s11[e], s21[e]}; }
            }
        }
    }
};

namespace att {
constexpr int KROW = 200, VROW = 72, KBYTES = 64 * KROW * 2, VBYTES = 128 * VROW * 2, BUFB = KBYTES + VBYTES;
__device__ __forceinline__ int crow(int r, int hi) { return (r & 3) + 8 * (r >> 2) + 4 * hi; }

__device__ __forceinline__ void attn_unit(LAS unsigned char* lds, int b, int h, int qb, const bf16_t* Qn, const bf16_t* Qr, const bf16_t* __restrict__ Kn,
                                          const bf16_t* __restrict__ Kr, const bf16_t* __restrict__ Vt, bf16_t* O) {
    int tid_ = threadIdx.x; asm volatile("" : "+v"(tid_));
    const int tid = tid_, lane = tid & 63, r32 = lane & 31, hi = lane >> 5, wid = __builtin_amdgcn_readfirstlane(tid >> 6);
    const int tok0 = b * SEQ, q0 = qb * 256;
    const int qtok = tok0 + q0 + wid * 32 + r32;
    bf16x8 qf[12];
#pragma unroll
    for (int ks = 0; ks < 8; ++ks) qf[ks] = *(const bf16x8*)(Qn + (size_t)qtok * 1024 + h * 128 + ks * 16 + hi * 8);
#pragma unroll
    for (int ks = 0; ks < 4; ++ks) qf[8 + ks] = *(const bf16x8*)(Qr + (size_t)qtok * 512 + h * 64 + ks * 16 + hi * 8);
    f32x16 o[4];
#pragma unroll
    for (int d = 0; d < 4; ++d)
#pragma unroll
        for (int r = 0; r < 16; ++r) o[d][r] = 0.f;
    float mrow = -INFINITY, lrow = 0.f;
    const int NT = 4 * (qb + 1);
    u32x4 st[5];
    const int krow0 = tid >> 4, kcc = tid & 15, rrow = tid >> 3, rcc = tid & 7;
    const bf16_t* kn_src = Kn + (size_t)(tok0 + krow0) * 1024 + h * 128 + kcc * 8;
    const bf16_t* kr_src = Kr + (size_t)(tok0 + rrow) * 64 + rcc * 8;
    const bf16_t* vt_src = Vt + (size_t)(h * 128 + rrow) * M + tok0 + rcc * 8;
#define ATT_LOAD(j) do { const size_t tb_ = (size_t)(j) * 64; \
        st[0] = *(const u32x4*)(kn_src + tb_ * 1024); st[1] = *(const u32x4*)(kn_src + (tb_ + 32) * 1024); \
        st[2] = *(const u32x4*)(kr_src + tb_ * 64); \
        st[3] = *(const u32x4*)(vt_src + tb_); st[4] = *(const u32x4*)(vt_src + (size_t)64 * M + tb_); } while (0)
#define ATT_STORE(buf) do { LAS unsigned char* ks_ = lds + (buf) * BUFB; LAS unsigned char* vs_ = ks_ + KBYTES; \
        *(LAS u32x4*)(ks_ + (krow0 * KROW + kcc * 8) * 2) = st[0]; *(LAS u32x4*)(ks_ + ((krow0 + 32) * KROW + kcc * 8) * 2) = st[1]; \
        *(LAS u32x4*)(ks_ + (rrow * KROW + 128 + rcc * 8) * 2) = st[2]; \
        *(LAS u32x4*)(vs_ + (rrow * VROW + rcc * 8) * 2) = st[3]; *(LAS u32x4*)(vs_ + ((rrow + 64) * VROW + rcc * 8) * 2) = st[4]; } while (0)
    ATT_LOAD(0);
    for (int j = 0; j < NT; ++j) {
        const int buf = j & 1;
        ATT_STORE(buf);
        __syncthreads();
        if (j + 1 < NT) ATT_LOAD(j + 1);
        const LAS unsigned char* kp = lds + buf * BUFB + (r32 * KROW + hi * 8) * 2;
        const LAS unsigned char* vp = lds + buf * BUFB + KBYTES + (r32 * VROW + hi * 8) * 2;
        f32x16 p0, p1;
#pragma unroll
        for (int r = 0; r < 16; ++r) { p0[r] = 0.f; p1[r] = 0.f; }
#pragma unroll
        for (int ks = 0; ks < 12; ++ks) {
            const bf16x8 a0 = *(const LAS bf16x8*)(kp + ks * 32), a1 = *(const LAS bf16x8*)(kp + 32 * KROW * 2 + ks * 32);
            p0 = __builtin_amdgcn_mfma_f32_32x32x16_bf16(a0, qf[ks], p0, 0, 0, 0);
            p1 = __builtin_amdgcn_mfma_f32_32x32x16_bf16(a1, qf[ks], p1, 0, 0, 0);
        }
        const int jb = j - (NT - 4);
        if (jb >= 0 && 64 * jb + 63 > wid * 32) {
            const int qrel = wid * 32 + r32, kb = 64 * jb + 4 * hi;
#pragma unroll
            for (int r = 0; r < 16; ++r) { const int kv = kb + (r & 3) + 8 * (r >> 2); if (kv > qrel) p0[r] = -INFINITY; if (kv + 32 > qrel) p1[r] = -INFINITY; }
        }
        float mx = fmaxf(p0[0], p1[0]);
#pragma unroll
        for (int r = 1; r < 16; ++r) mx = fmaxf(mx, fmaxf(p0[r], p1[r]));
        mx = fmaxf(mx, __shfl_xor(mx, 32));
        const float mnew = fmaxf(mrow, mx);
        const float alpha = __builtin_amdgcn_exp2f(mrow - mnew);
        mrow = mnew;
        float ls = 0.f;
#pragma unroll
        for (int r = 0; r < 16; ++r) { p0[r] = __builtin_amdgcn_exp2f(p0[r] - mnew); p1[r] = __builtin_amdgcn_exp2f(p1[r] - mnew); ls += p0[r] + p1[r]; }
        lrow = lrow * alpha + ls;
#pragma unroll
        for (int d = 0; d < 4; ++d)
#pragma unroll
            for (int r = 0; r < 16; ++r) o[d][r] *= alpha;
        bf16x8 pk[4];
        { u32x4 w;
          w.x = cvt_pk_bf16(p0[0], p0[1]); w.y = cvt_pk_bf16(p0[2], p0[3]); w.z = cvt_pk_bf16(p0[4], p0[5]); w.w = cvt_pk_bf16(p0[6], p0[7]); pk[0] = __builtin_bit_cast(bf16x8, w);
          w.x = cvt_pk_bf16(p0[8], p0[9]); w.y = cvt_pk_bf16(p0[10], p0[11]); w.z = cvt_pk_bf16(p0[12], p0[13]); w.w = cvt_pk_bf16(p0[14], p0[15]); pk[1] = __builtin_bit_cast(bf16x8, w);
          w.x = cvt_pk_bf16(p1[0], p1[1]); w.y = cvt_pk_bf16(p1[2], p1[3]); w.z = cvt_pk_bf16(p1[4], p1[5]); w.w = cvt_pk_bf16(p1[6], p1[7]); pk[2] = __builtin_bit_cast(bf16x8, w);
          w.x = cvt_pk_bf16(p1[8], p1[9]); w.y = cvt_pk_bf16(p1[10], p1[11]); w.z = cvt_pk_bf16(p1[12], p1[13]); w.w = cvt_pk_bf16(p1[14], p1[15]); pk[3] = __builtin_bit_cast(bf16x8, w); }
#pragma unroll
        for (int d = 0; d < 4; ++d)
#pragma unroll
            for (int ks = 0; ks < 4; ++ks) {
                const bf16x8 a = *(const LAS bf16x8*)(vp + d * 32 * VROW * 2 + ks * 32);
                o[d] = __builtin_amdgcn_mfma_f32_32x32x16_bf16(a, pk[ks], o[d], 0, 0, 0);
            }
    }
#undef ATT_LOAD
#undef ATT_STORE
    const float ltot = lrow + __shfl_xor(lrow, 32);
    const float inv = 1.0f / ltot;
    bf16_t* op = O + (size_t)qtok * 1024 + h * 128 + 4 * hi;
#pragma unroll
    for (int d = 0; d < 4; ++d)
#pragma unroll
        for (int rg = 0; rg < 4; ++rg) { u32x2 w; w.x = cvt_pk_bf16(o[d][4 * rg] * inv, o[d][4 * rg + 1] * inv); w.y = cvt_pk_bf16(o[d][4 * rg + 2] * inv, o[d][4 * rg + 3] * inv);
            *(u32x2*)(op + 32 * d + 8 * rg) = w; }
}
}

namespace sgu {
constexpr int AROW = 136;
constexpr int A_BYTES = 256 * AROW * 2, B_BYTES = 128 * AROW * 2, ST_OFF = A_BYTES + B_BYTES;
__device__ __forceinline__ void item(LAS unsigned char* lds, int c, int g, const bf16_t* __restrict__ vT, const float* __restrict__ lnst, const float* __restrict__ lng,
                                     const float* __restrict__ lnb, const bf16_t* __restrict__ wsp, const float* __restrict__ bsp, bf16_t* U) {
    int tid_ = threadIdx.x; asm volatile("" : "+v"(tid_));
    const int tid = tid_, lane = tid & 63, r32 = lane & 31, hi = lane >> 5, wid = __builtin_amdgcn_readfirstlane(tid >> 6);
    const int tokbase = c * 128;
    LAS float* mu = (LAS float*)(lds + ST_OFF); LAS float* rs = mu + 128;
    if (tid < 128) {
        const float* p = lnst + (size_t)(tokbase + tid) * 32; float s1 = 0.f, s2 = 0.f;
#pragma unroll
        for (int i = 0; i < 8; ++i) { const f32x4 v = *(const f32x4*)(p + 4 * i); s1 += v[0] + v[2]; s2 += v[1] + v[3]; }
        const float mean = s1 * (1.0f / 2048.0f), var = fmaxf(s2 * (1.0f / 2048.0f) - mean * mean, 0.f);
        mu[tid] = mean; rs[tid] = 1.0f / sqrtf(var + LN_EPS);
    }
#pragma unroll
    for (int i = 0; i < 4; ++i) { const int ch = tid + 512 * i, t = ch >> 4, cc = ch & 15;
        *(LAS u32x4*)(lds + A_BYTES + (t * AROW + cc * 8) * 2) = *(const u32x4*)(wsp + ((size_t)g * 128 + t) * 128 + cc * 8); }
    __syncthreads();
#pragma unroll
    for (int i = 0; i < 8; ++i) { const int ch = tid + 512 * i, d = ch >> 4, cc = ch & 15;
        const u32x4 raw = *(const u32x4*)(vT + (size_t)(g * 256 + d) * M + tokbase + cc * 8);
        const float gg = lng[g * 256 + d], bb = lnb[g * 256 + d];
        float v[8];
#pragma unroll
        for (int e = 0; e < 4; ++e) { const unsigned w = raw[e]; v[2 * e] = __builtin_bit_cast(float, w << 16); v[2 * e + 1] = __builtin_bit_cast(float, w & 0xffff0000u); }
#pragma unroll
        for (int e = 0; e < 8; ++e) { const int s = cc * 8 + e; v[e] = (v[e] - mu[s]) * rs[s] * gg + bb; }
        u32x4 w; w.x = cvt_pk_bf16(v[0], v[1]); w.y = cvt_pk_bf16(v[2], v[3]); w.z = cvt_pk_bf16(v[4], v[5]); w.w = cvt_pk_bf16(v[6], v[7]);
        *(LAS u32x4*)(lds + (d * AROW + cc * 8) * 2) = w; }
    __syncthreads();
    f32x16 acc[4];
#pragma unroll
    for (int tb = 0; tb < 4; ++tb)
#pragma unroll
        for (int r = 0; r < 16; ++r) acc[tb][r] = 0.f;
    const LAS unsigned char* ap = lds + ((wid * 32 + r32) * AROW + hi * 8) * 2;
    const LAS unsigned char* bp = lds + A_BYTES + (r32 * AROW + hi * 8) * 2;
#pragma unroll
    for (int ks = 0; ks < 8; ++ks) {
        const bf16x8 a = *(const LAS bf16x8*)(ap + ks * 32);
#pragma unroll
        for (int tb = 0; tb < 4; ++tb) if (16 * ks <= 32 * tb + 31) {
            const bf16x8 bq = *(const LAS bf16x8*)(bp + tb * 32 * AROW * 2 + ks * 32);
            acc[tb] = __builtin_amdgcn_mfma_f32_32x32x16_bf16(a, bq, acc[tb], 0, 0, 0);
        }
    }
#pragma unroll
    for (int tb = 0; tb < 4; ++tb) { const int t = tb * 32 + r32; const float bias = bsp[g * 128 + t];
        bf16_t* up = U + (size_t)(tokbase + t) * SGW + g * 256 + wid * 32 + 4 * hi;
#pragma unroll
        for (int rg = 0; rg < 4; ++rg) { const u32x2 uu = *(const u32x2*)(up + 8 * rg);
            const float u0 = __builtin_bit_cast(float, uu.x << 16), u1 = __builtin_bit_cast(float, uu.x & 0xffff0000u), u2 = __builtin_bit_cast(float, uu.y << 16), u3 = __builtin_bit_cast(float, uu.y & 0xffff0000u);
            u32x2 w; w.x = cvt_pk_bf16(u0 * (acc[tb][4 * rg] + bias), u1 * (acc[tb][4 * rg + 1] + bias)); w.y = cvt_pk_bf16(u2 * (acc[tb][4 * rg + 2] + bias), u3 * (acc[tb][4 * rg + 3] + bias));
            *(u32x2*)(up + 8 * rg) = w; } }
    __syncthreads();
}
}

__device__ __forceinline__ float wave_sum(float v) {
#pragma unroll
    for (int o = 1; o < 64; o <<= 1) v += __shfl_xor(v, o);
    return v;
}
template <class F>
__device__ __forceinline__ void conv_matrix(const F& f, bf16_t* WT, int Kd, int Nd, LAS float* scr, int gw, int NGW, int lane_) {
    (void)lane_; int lt_ = threadIdx.x; asm volatile("" : "+v"(lt_)); const int lane = lt_ & 63;
    const int nblk = Nd / 32, nitems = (Kd / 64) * nblk;
    for (int it = gw; it < nitems; it += NGW) {
        const int kb = it / nblk, nb = it % nblk, k0 = 64 * kb, n0 = 32 * nb;
#pragma unroll 8
        for (int i = 0; i < 32; ++i) { const int kk = 2 * i + (lane >> 5); scr[kk * 33 + (lane & 31)] = f(k0 + kk, n0 + (lane & 31)); }
        asm volatile("s_waitcnt lgkmcnt(0)" ::: "memory");
        const int c = lane & 7;
#pragma unroll
        for (int j = 0; j < 4; ++j) { const int n = (lane >> 3) + 8 * j; const LAS float* s = scr + (8 * c) * 33 + n;
            u32x4 o; o.x = cvt_pk_bf16(s[0 * 33], s[1 * 33]); o.y = cvt_pk_bf16(s[2 * 33], s[3 * 33]); o.z = cvt_pk_bf16(s[4 * 33], s[5 * 33]); o.w = cvt_pk_bf16(s[6 * 33], s[7 * 33]);
            *(u32x4*)(WT + (size_t)(n0 + n) * Kd + k0 + 8 * c) = o; }
        asm volatile("s_waitcnt lgkmcnt(0)" ::: "memory");
    }
}

struct Args {
    const float* x; const int* pos; const float* norm_mix; const float* norm_ffn; const float* final_norm;
    const float* w_dkv; const float* q_norm; const float* kv_norm; const float* w_uq; const float* w_ukv; const float* w_o;
    const float* w_in; const float* ln_g; const float* ln_b; const float* w_sp; const float* b_sp; const float* w_out;
    const float* w_up; const float* w_down;
    float* out; unsigned char* ws;
};

__device__ __forceinline__ void conv_set_a(const Args& a, int j, LAS float* scr, int gw, int NGW, int lane) {
    const int L = 2 * j;
    unsigned char* wa = a.ws + WS_WA;
    { const float* W = a.w_dkv + (size_t)j * 1024 * 448; const float* g = a.norm_mix + L * 1024;
      auto f = [=](int k, int n) -> float { int c;
          if (n < 256) c = n; else { const int l = n - 256, h2 = l >> 7, ll = l & 127; c = ll < 64 ? 256 + h2 * 64 + ll : (ll < 96 ? 384 + h2 * 32 + (ll - 64) : -1); }
          return c < 0 ? 0.f : W[(size_t)k * 448 + c] * g[k]; };
      conv_matrix(f, (bf16_t*)(wa + WA_LAT), 1024, 512, scr, gw, NGW, lane); }
    { const float* Wq = a.w_uq + (size_t)j * 256 * 1536; const float* Wkv = a.w_ukv + (size_t)j * 128 * 2048; const float* gq = a.q_norm + j * 256; const float* gk = a.kv_norm + j * 128;
      auto f = [=](int k, int n) -> float {
          if (n < 1536) { if (k >= 256) return 0.f; int c;
              if (n < 1024) c = (n >> 7) * 192 + (n & 127); else { const int l = n - 1024, uu = l >> 8, ll = l & 255, half = ll >> 7, hh = (ll & 127) >> 5, jj = ll & 31; c = (uu * 4 + hh) * 192 + 128 + half * 32 + jj; }
              return Wq[(size_t)k * 1536 + c] * gq[k]; }
          if (k < 256) return 0.f; const int l = n - 1536; return Wkv[(size_t)(k - 256) * 2048 + (l >> 7) * 256 + (l & 127)] * gk[k - 256]; };
      conv_matrix(f, (bf16_t*)(wa + WA_QK), LATK, 2560, scr, gw, NGW, lane); }
    { const float* Wkv = a.w_ukv + (size_t)j * 128 * 2048; const float* gk = a.kv_norm + j * 128;
      auto f = [=](int k, int n) -> float { if (k < 256) return 0.f; return Wkv[(size_t)(k - 256) * 2048 + (n >> 7) * 256 + 128 + (n & 127)] * gk[k - 256]; };
      conv_matrix(f, (bf16_t*)(wa + WA_V), LATK, 1024, scr, gw, NGW, lane); }
    { const float* W = a.w_o + (size_t)j * 1024 * 1024;
      auto f = [=](int k, int n) -> float { return W[(size_t)k * 1024 + n]; };
      conv_matrix(f, (bf16_t*)(wa + WA_O), 1024, 1024, scr, gw, NGW, lane); }
    { const float* W = a.w_up + (size_t)L * 1024 * 4096; const float* g = a.norm_ffn + L * 1024;
      auto f = [=](int k, int n) -> float { return W[(size_t)k * 4096 + n] * g[k]; };
      conv_matrix(f, (bf16_t*)(wa + WA_UP), 1024, 4096, scr, gw, NGW, lane); }
    { const float* W = a.w_down + (size_t)L * 4096 * 1024;
      auto f = [=](int k, int n) -> float { return W[(size_t)k * 1024 + n]; };
      conv_matrix(f, (bf16_t*)(wa + WA_DN), 4096, 1024, scr, gw, NGW, lane); }
}
__device__ __forceinline__ void conv_set_b(const Args& a, int j, LAS float* scr, int gw, int NGW, int lane) {
    const int L = 2 * j + 1;
    unsigned char* wb = a.ws + WS_WB;
    { const float* W = a.w_in + (size_t)j * 1024 * 4096; const float* g = a.norm_mix + L * 1024;
      auto f = [=](int k, int n) -> float { return W[(size_t)k * 4096 + n] * g[k]; };
      conv_matrix(f, (bf16_t*)(wb + WB_INU), 1024, 2048, scr, gw, NGW, lane);
      auto f2 = [=](int k, int n) -> float { return W[(size_t)k * 4096 + 2048 + n] * g[k]; };
      conv_matrix(f2, (bf16_t*)(wb + WB_INV), 1024, 2048, scr, gw, NGW, lane); }
    { const float* W = a.w_out + (size_t)j * 2048 * 1024;
      auto f = [=](int k, int n) -> float { return W[(size_t)k * 1024 + n]; };
      conv_matrix(f, (bf16_t*)(wb + WB_OUT), 2048, 1024, scr, gw, NGW, lane); }
    { const float* W = a.w_up + (size_t)L * 1024 * 4096; const float* g = a.norm_ffn + L * 1024;
      auto f = [=](int k, int n) -> float { return W[(size_t)k * 4096 + n] * g[k]; };
      conv_matrix(f, (bf16_t*)(wb + WB_UP), 1024, 4096, scr, gw, NGW, lane); }
    { const float* W = a.w_down + (size_t)L * 4096 * 1024;
      auto f = [=](int k, int n) -> float { return W[(size_t)k * 1024 + n]; };
      conv_matrix(f, (bf16_t*)(wb + WB_DN), 4096, 1024, scr, gw, NGW, lane); }
}


#define XB_TMO      128
#define XB_XCNT(j)  (256  + 64 * (j))
#define XB_XSUB(j)  (1280 + 64 * (j))
#define XB_XGEN(j)  (2304 + 64 * (j))
#define XB_TOP      3328
#define XB_TOPGEN   3392
#define XCD_BAR_WORDS 3456
#define XB_SPIN_CAP (1u << 22)
__device__ __forceinline__ unsigned xb_ld(unsigned* p)              { return __hip_atomic_load(p, __ATOMIC_RELAXED, __HIP_MEMORY_SCOPE_AGENT); }
__device__ __forceinline__ unsigned xb_add(unsigned* p, unsigned v) { return __hip_atomic_fetch_add(p, v, __ATOMIC_RELAXED, __HIP_MEMORY_SCOPE_AGENT); }
__device__ __forceinline__ unsigned xb_xcc_id() { return (unsigned)__builtin_amdgcn_s_getreg((3 << 11) | 20) & 0xFu; }
#define XB_SPIN(cond, bar) do { unsigned _sp = 0; while (cond) { __builtin_amdgcn_s_sleep(1); \
    if ((++_sp & 255u) == 0u) { if (xb_ld(&(bar)[XB_TMO])) break; if (_sp > XB_SPIN_CAP) { atomicAdd(&(bar)[XB_TMO], 1u); break; } } } } while (0)
struct XcdBarrier { unsigned* bar; unsigned x; volatile LAS unsigned* st; };
__device__ __forceinline__ XcdBarrier xcd_barrier_post(unsigned* bar, volatile LAS unsigned* st) {
    XcdBarrier b; b.bar = bar; b.x = xb_xcc_id(); b.st = st;
    if (threadIdx.x == 0) (void)xb_add(&bar[XB_XCNT(b.x)], 1u);
    return b;
}
__device__ __forceinline__ void xcd_barrier_complete(unsigned* bar, unsigned x, unsigned& nloc, unsigned& nx) {
    const unsigned G = gridDim.x * gridDim.y * gridDim.z;
    unsigned sum, cnt, mine, sp = 0u;
    for (;;) {
        sum = 0u; cnt = 0u; mine = 0u;
#pragma unroll
        for (unsigned j = 0; j < 16; ++j) { const unsigned c = xb_ld(&bar[XB_XCNT(j)]); sum += c; cnt += (c > 0u) ? 1u : 0u; mine = (j == x) ? c : mine; }
        if (sum == G) break;
        __builtin_amdgcn_s_sleep(1);
        if ((++sp & 255u) == 0u) { if (xb_ld(&bar[XB_TMO])) break; if (sp > XB_SPIN_CAP) { atomicAdd(&bar[XB_TMO], 1u); break; } }
    }
    nloc = mine > 0u ? mine : 1u; nx = cnt > 0u ? cnt : 1u;
}
__device__ __forceinline__ void xcd_barrier(const XcdBarrier& b) {
    asm volatile("s_waitcnt vmcnt(0)" ::: "memory");
    __syncthreads();
    if (threadIdx.x == 0) {
        unsigned* bar = b.bar;
        __builtin_amdgcn_s_waitcnt(0);
        unsigned nloc = b.st[0], nx = b.st[1];
        if (nloc == 0u) { xcd_barrier_complete(bar, b.x, nloc, nx); b.st[0] = nloc; b.st[1] = nx; }
        const unsigned old = xb_add(&bar[XB_XSUB(b.x)], 1u);
        const unsigned gen = old / nloc;
        if (old + 1u == (gen + 1u) * nloc) {
            __builtin_amdgcn_fence(__ATOMIC_RELEASE, "agent");
            asm volatile("s_waitcnt vmcnt(0)" ::: "memory");
            const unsigned og = xb_add(&bar[XB_TOP], 1u);
            const unsigned tg = og / nx;
            if (og + 1u == (tg + 1u) * nx) xb_add(&bar[XB_TOPGEN], 1u);
            else XB_SPIN(xb_ld(&bar[XB_TOPGEN]) == tg, bar);
            __builtin_amdgcn_fence(__ATOMIC_ACQUIRE, "agent");
            xb_add(&bar[XB_XGEN(b.x)], 1u);
            asm volatile("s_waitcnt vmcnt(0)" ::: "memory");
        } else {
            XB_SPIN(xb_ld(&bar[XB_XGEN(b.x)]) == gen, bar);
            __builtin_amdgcn_fence(__ATOMIC_ACQUIRE, "agent");
            asm volatile("s_waitcnt vmcnt(0)" ::: "memory");
        }
    }
    __syncthreads();
}

__global__ void __launch_bounds__(512, 2) mega_fwd(Args a) {
    extern __shared__ __attribute__((aligned(16))) unsigned char lds_raw[];
    LAS unsigned char* lds = (LAS unsigned char*)lds_raw;
    cg::grid_group grid = cg::this_grid();
    const int tid = threadIdx.x, lane = tid & 63, wave = __builtin_amdgcn_readfirstlane(tid >> 6);
    const int G = gridDim.x, bx = blockIdx.x;
    const int gw = bx * 8 + wave, NGW = G * 8;
    unsigned char* ws = a.ws;
    float* ssqx = (float*)(ws + WS_SSQX); float* ssqq = (float*)(ws + WS_SSQQ); float* ssqkv = (float*)(ws + WS_SSQKV); float* lnst = (float*)(ws + WS_LNST);
    float* cst = (float*)(ws + WS_COS); float* snt = (float*)(ws + WS_SIN);
    bf16_t* KR = (bf16_t*)(ws + WS_KR); bf16_t* WSP = (bf16_t*)(ws + WS_WSP);
    bf16_t* XB = (bf16_t*)(ws + WS_XB);
    unsigned char* hb = ws + WS_HB; unsigned char* wa = ws + WS_WA; unsigned char* wb = ws + WS_WB;
    bf16_t* HB = (bf16_t*)hb;
    bf16_t* LAT = (bf16_t*)(hb + HB_LAT); bf16_t* QN = (bf16_t*)(hb + HB_QN); bf16_t* QR = (bf16_t*)(hb + HB_QR); bf16_t* KN = (bf16_t*)(hb + HB_KN); bf16_t* VT = (bf16_t*)(hb + HB_VT);
    bf16_t* UB = (bf16_t*)(hb + HB_U); bf16_t* VTS = (bf16_t*)(hb + HB_VTS);
    float* X32 = a.out;
    LAS float* scr = (LAS float*)(lds + wave * 16384);
    volatile LAS unsigned* MISC = (volatile LAS unsigned*)(lds + 131072);
    if (tid < 64) MISC[tid] = 0u;
    unsigned* ctl = (unsigned*)(ws + WS_CTL);
    if (bx == 0) for (int i = tid; i < XCD_BAR_WORDS; i += 512) __hip_atomic_store(ctl + i, 0u, __ATOMIC_RELAXED, __HIP_MEMORY_SCOPE_AGENT);
    __syncthreads();

    conv_set_a(a, 0, scr, gw, NGW, lane);
    conv_set_b(a, 0, scr, gw, NGW, lane);
    for (int i = gw * 64 + lane; i < 2 * 8 * 128 * 128; i += NGW * 64) { const int s = i & 127, t = (i >> 7) & 127; WSP[i] = (bf16_t)(cvt_pk_bf16(s <= t ? a.w_sp[i] : 0.f, 0.f) & 0xffffu); }
    for (int i = gw * 64 + lane; i < M * 32; i += NGW * 64) { const int tok = i >> 5, fi = i & 31;
        const float inv_freq = exp2f(-(float)(2 * fi) * (13.287712379549449f / 64.0f));
        const float ang = (float)a.pos[tok] * inv_freq;
        const double rev = (double)ang * 0.15915494309189535; const float fr = (float)(rev - __builtin_rint(rev));
        cst[i] = __builtin_amdgcn_cosf(fr); snt[i] = __builtin_amdgcn_sinf(fr); }
    for (int m = gw; m < M; m += NGW) {
        const f32x4* xr = (const f32x4*)(a.x + (size_t)m * DM) + lane;
#pragma unroll
        for (int jj = 0; jj < 4; ++jj) { const f32x4 v = xr[64 * jj]; float s = dot4(v);
            u32x2 w; w.x = cvt_pk_bf16(v[0], v[1]); w.y = cvt_pk_bf16(v[2], v[3]);
            *(u32x2*)(XB + (size_t)m * DM + 256 * jj + 4 * lane) = w;
            s += __shfl_xor(s, 1); s += __shfl_xor(s, 2); s += __shfl_xor(s, 4); s += __shfl_xor(s, 8);
            if ((lane & 15) == 0) ssqx[(size_t)m * 16 + 4 * jj + (lane >> 4)] = s; }
    }
    grid.sync();
    const XcdBarrier xbar = xcd_barrier_post(ctl, MISC + 8);

    for (int L = 0; L < 4; ++L) {
        const int j = L >> 1;
        if ((L & 1) == 0) {
            { pg8::Gemm g{XB, (const bf16_t*)(wa + WA_LAT), M, 512, 1024, 1024, 1024}; pg8::StaticOrder S; S.init(M, 512, G, bx);
              EpiLat E{LAT, KR, ssqx, ssqq, ssqkv, cst, snt};
              pg8::gemm_phase(lds, g, S, E); }
            xcd_barrier(xbar);
            { pg8::Gemm g{LAT, (const bf16_t*)(wa + WA_QK), M, 2560, LATK, LATK, LATK}; pg8::StaticOrder S; S.init(M, 2560, G, bx);
              EpiQK E{QN, QR, KN, ssqq, ssqkv, cst, snt};
              pg8::gemm_phase(lds, g, S, E); }
            { pg8::Gemm g{(const bf16_t*)(wa + WA_V), LAT, 1024, M, LATK, LATK, LATK}; pg8::StaticOrder S; S.init(1024, M, G, bx);
              EpiVT E{VT, ssqkv};
              pg8::gemm_phase(lds, g, S, E); }
            xcd_barrier(xbar);
            { const int nsl = (G == 256) ? 1 : 0;
              for (int p0 = bx; p0 < 256; p0 += G) {
                  const int p = nsl ? ((p0 & 7) * 32 + (p0 >> 3)) : p0;
                  const int bh = p >> 3, pi = p & 7;
                  att::attn_unit(lds, bh >> 3, bh & 7, 15 - pi, QN, QR, KN, KR, VT, QN);
                  att::attn_unit(lds, bh >> 3, bh & 7, pi, QN, QR, KN, KR, VT, QN);
              }
              __syncthreads(); }
            if (L == 2) conv_set_b(a, 1, scr, gw, NGW, lane);
            xcd_barrier(xbar);
            { pg8::Gemm g{QN, (const bf16_t*)(wa + WA_O), M, 1024, 1024, 1024, 1024}; pg8::StaticOrder S; S.init(M, 1024, G, bx);
              EpiRes E{L == 0 ? a.x : X32, X32, XB, ssqx};
              pg8::gemm_phase(lds, g, S, E); }
            xcd_barrier(xbar);
        } else {
            { pg8::Gemm g{XB, (const bf16_t*)(wb + WB_INU), M, SGW, 1024, 1024, 1024}; pg8::StaticOrder S; S.init(M, SGW, G, bx);
              EpiU E{UB, ssqx};
              pg8::gemm_phase(lds, g, S, E); }
            { pg8::Gemm g{(const bf16_t*)(wb + WB_INV), XB, SGW, M, 1024, 1024, 1024}; pg8::StaticOrder S; S.init(SGW, M, G, bx);
              EpiVTS E{VTS, ssqx, lnst};
              pg8::gemm_phase(lds, g, S, E); }
            xcd_barrier(xbar);
            { const bf16_t* wsp = WSP + (size_t)j * 8 * 128 * 128; const float* bsp = a.b_sp + j * 8 * 128;
              for (int it = bx; it < 1024; it += G) sgu::item(lds, it >> 3, it & 7, VTS, lnst, a.ln_g + j * SGW, a.ln_b + j * SGW, wsp, bsp, UB); }
            if (L == 1) conv_set_a(a, 1, scr, gw, NGW, lane);
            xcd_barrier(xbar);
            { pg8::Gemm g{UB, (const bf16_t*)(wb + WB_OUT), M, 1024, SGW, SGW, SGW}; pg8::StaticOrder S; S.init(M, 1024, G, bx);
              EpiRes E{X32, X32, XB, ssqx};
              pg8::gemm_phase(lds, g, S, E); }
            xcd_barrier(xbar);
        }
        unsigned char* wl = (L & 1) ? wb : wa;
        const size_t off_up = (L & 1) ? WB_UP : WA_UP, off_dn = (L & 1) ? WB_DN : WA_DN;
        { pg8::Gemm g{XB, (const bf16_t*)(wl + off_up), M, FF, 1024, 1024, 1024}; pg8::StaticOrder S; S.init(M, FF, G, bx);
          EpiUp E{HB, ssqx};
          pg8::gemm_phase(lds, g, S, E); }
        xcd_barrier(xbar);
        { pg8::Gemm g{HB, (const bf16_t*)(wl + off_dn), M, 1024, FF, FF, FF}; pg8::StaticOrder S; S.init(M, 1024, G, bx);
          EpiRes E{X32, X32, XB, ssqx};
          pg8::gemm_phase(lds, g, S, E); }
        xcd_barrier(xbar);
    }
    int lt2_ = threadIdx.x; asm volatile("" : "+v"(lt2_)); const int lane2 = lt2_ & 63;
    for (int m = gw; m < M; m += NGW) {
        f32x4* xr = (f32x4*)(X32 + (size_t)m * DM) + lane2; const f32x4* gr = (const f32x4*)a.final_norm + lane2;
        f32x4 v[4]; float s = 0.f;
#pragma unroll
        for (int jj = 0; jj < 4; ++jj) { v[jj] = xr[64 * jj]; s += dot4(v[jj]); }
        const float r = 1.0f / sqrtf(wave_sum(s) * (1.0f / 1024.0f) + NORM_EPS);
#pragma unroll
        for (int jj = 0; jj < 4; ++jj) xr[64 * jj] = v[jj] * r * gr[64 * jj];
    }
}

extern "C" void kernel_launch(void* const* d_in, const int* in_sizes, int n_in, void* d_out, int out_size, void* d_ws, size_t ws_size, hipStream_t stream) {
    static int grid = 0;
    if (grid == 0) {
        if (n_in != 19 || out_size != M * DM || ws_size < WS_END) { fprintf(stderr, "kernel_launch: unexpected shapes (n_in %d out %d ws %zu)\n", n_in, out_size, ws_size); grid = -1; return; }
        int dev = 0, cus = 0, per_cu = 0;
        hipGetDevice(&dev); hipDeviceGetAttribute(&cus, hipDeviceAttributeMultiprocessorCount, dev);
        hipFuncSetAttribute((const void*)mega_fwd, hipFuncAttributeMaxDynamicSharedMemorySize, LDS_BYTES);
        hipOccupancyMaxActiveBlocksPerMultiprocessor(&per_cu, (const void*)mega_fwd, 512, LDS_BYTES);
        if (per_cu < 1) { fprintf(stderr, "kernel_launch: occupancy query returned %d\n", per_cu); per_cu = 1; }
        grid = cus * per_cu;
    }
    if (grid < 0) return;
    Args a{};
    a.x = (const float*)d_in[0]; a.pos = (const int*)d_in[1]; a.norm_mix = (const float*)d_in[2]; a.norm_ffn = (const float*)d_in[3]; a.final_norm = (const float*)d_in[4];
    a.w_dkv = (const float*)d_in[5]; a.q_norm = (const float*)d_in[6]; a.kv_norm = (const float*)d_in[7]; a.w_uq = (const float*)d_in[8]; a.w_ukv = (const float*)d_in[9]; a.w_o = (const float*)d_in[10];
    a.w_in = (const float*)d_in[11]; a.ln_g = (const float*)d_in[12]; a.ln_b = (const float*)d_in[13]; a.w_sp = (const float*)d_in[14]; a.b_sp = (const float*)d_in[15]; a.w_out = (const float*)d_in[16];
    a.w_up = (const float*)d_in[17]; a.w_down = (const float*)d_in[18];
    a.out = (float*)d_out; a.ws = (unsigned char*)d_ws;
    void* args[] = {&a};
    hipError_t e = hipLaunchCooperativeKernel((const void*)mega_fwd, dim3(grid), dim3(512), args, LDS_BYTES, stream);
    if (e != hipSuccess) fprintf(stderr, "cooperative launch failed: %s (grid %d)\n", hipGetErrorString(e), grid);
}
```

```cpp
#include <hip/hip_runtime.h>
#include <hip/hip_cooperative_groups.h>
#include <cstdio>
#include <cstdint>
namespace cg = cooperative_groups;

#define LAS __attribute__((address_space(3)))
typedef unsigned short bf16_t;
typedef short bf16x8 __attribute__((ext_vector_type(8)));
typedef float f32x4 __attribute__((ext_vector_type(4)));
typedef float f32x2 __attribute__((ext_vector_type(2)));
typedef float f32x16 __attribute__((ext_vector_type(16)));
typedef unsigned u32x4 __attribute__((ext_vector_type(4)));
typedef unsigned u32x2 __attribute__((ext_vector_type(2)));

constexpr int M = 16384, DM = 1024, SEQ = 4096, NH = 8, FF = 4096, SGW = 2048;
constexpr int LATK = 384;
constexpr float NORM_EPS = 1e-6f, LN_EPS = 1e-5f;
constexpr float QSCALE = 0.07216878364870322f * 1.4426950408889634f;

constexpr size_t MiB = 1u << 20;
constexpr size_t WS_SSQX = 0;
constexpr size_t WS_SSQQ = 1 * MiB;
constexpr size_t WS_SSQKV = 1 * MiB + 256 * 1024;
constexpr size_t WS_LNST = 2 * MiB;
constexpr size_t WS_COS = 4 * MiB, WS_SIN = 6 * MiB;
constexpr size_t WS_KR = 8 * MiB;
constexpr size_t WS_WSP = 10 * MiB;
constexpr size_t WS_CTL = 12 * MiB;
constexpr size_t WS_WA = 16 * MiB;
constexpr size_t WA_LAT = 0, WA_QK = 1 * MiB, WA_V = 3 * MiB, WA_O = 4 * MiB, WA_UP = 6 * MiB, WA_DN = 14 * MiB;
constexpr size_t WS_WB = 40 * MiB;
constexpr size_t WB_INU = 0, WB_INV = 4 * MiB, WB_OUT = 8 * MiB, WB_UP = 12 * MiB, WB_DN = 20 * MiB;
constexpr size_t WS_XB = 72 * MiB;
constexpr size_t WS_HB = 104 * MiB;
constexpr size_t HB_LAT = 0, HB_QN = 16 * MiB, HB_QR = 48 * MiB, HB_KN = 64 * MiB, HB_VT = 96 * MiB;
constexpr size_t HB_U = 0, HB_VTS = 64 * MiB;
constexpr size_t WS_END = 232 * MiB;

constexpr int LDS_BYTES = 147456;

__device__ __forceinline__ unsigned cvt_pk_bf16(float lo, float hi) { unsigned r; asm volatile("v_cvt_pk_bf16_f32 %0, %1, %2" : "=v"(r) : "v"(lo), "v"(hi)); return r; }
__device__ __forceinline__ float bf2f(unsigned short b) { return __builtin_bit_cast(float, (unsigned)b << 16); }
__device__ __forceinline__ u32x4 pack8(f32x4 a, f32x4 b) { u32x4 w; w.x = cvt_pk_bf16(a[0], a[1]); w.y = cvt_pk_bf16(a[2], a[3]); w.z = cvt_pk_bf16(b[0], b[1]); w.w = cvt_pk_bf16(b[2], b[3]); return w; }
__device__ __forceinline__ float sum4(f32x4 v) { return (v[0] + v[1]) + (v[2] + v[3]); }
__device__ __forceinline__ float dot4(f32x4 v) { return (v[0] * v[0] + v[1] * v[1]) + (v[2] * v[2] + v[3] * v[3]); }
__device__ __forceinline__ f32x2 gelu_pk(f32x2 v) {
    const f32x2 av = __builtin_elementwise_abs(v), d = av * 0.2316418882f + 1.0f;
    f32x2 t; t.x = __builtin_amdgcn_rcpf(d.x); t.y = __builtin_amdgcn_rcpf(d.y);
    f32x2 q = t * 0.5307027145f + (-0.7265760135f); q = q * t + 0.7107068705f; q = q * t + (-0.142248368f); q = q * t + 0.127414796f; q = q * t;
    const f32x2 s = (v * v) * (-0.72134752044f);
    f32x2 e; e.x = __builtin_amdgcn_exp2f(s.x); e.y = __builtin_amdgcn_exp2f(s.y);
    const f32x2 m = v * (q * e), r = v - m;
    f32x2 o; o.x = v.x < 0.f ? m.x : r.x; o.y = v.y < 0.f ? m.y : r.y; return o;
}
__device__ __forceinline__ f32x4 gelu4(f32x4 v) { f32x2 a = gelu_pk((f32x2){v[0], v[1]}), b = gelu_pk((f32x2){v[2], v[3]}); return (f32x4){a.x, a.y, b.x, b.y}; }

namespace pg8 {
constexpr int BM = 256, BK = 64, HALF = 128, HTB = HALF * BK * 2, STAGE_BYTES = 8 * HTB, NXCD = 8, WGM = 8;
__device__ __forceinline__ int lds_byte(int r, int c) { const int st = (r >> 4) * 2 + (c >> 5), rr = r & 15, cc = c & 31, ob = rr * 64 + cc * 2; return st * 1024 + (ob ^ (((ob >> 9) & 1) << 5)); }
__device__ __forceinline__ void stage_rc(int b, int& R, int& C) { const int st = b / 1024, sb = b % 1024, swz = sb ^ (((sb >> 9) & 1) << 5); R = (st >> 1) * 16 + swz / 64; C = (st & 1) * 32 + (swz % 64) / 2; }
__device__ __forceinline__ int perm32(int rho) { const int n = rho >> 4, i = rho & 15; return 8 * (i >> 2) + 4 * n + (i & 3); }

struct Unit { int pm, pn; };
struct Gemm { const bf16_t* A; const bf16_t* Bt; int M, N, K, lda, ldb; };

struct StaticOrder {
    int nM, nN, nwg, G, c;
    __device__ void init(int M_, int N_, int G_, int c_) { asm volatile("" : "+s"(G_), "+s"(c_)); nM = M_ / BM; nN = N_ / BM; nwg = nM * nN; G = G_; c = c_; }
    __device__ bool next(int i, Unit& u) const {
        const long L = (long)i * G + c; if (L >= nwg) return false;
        int wgid = (int)L; { const int q = nwg / NXCD, r = nwg % NXCD, xcd = wgid % NXCD, off = wgid / NXCD; wgid = (xcd < r ? xcd * (q + 1) : r * (q + 1) + (xcd - r) * q) + off; }
        const int nig = WGM * nN, gid = wgid / nig, fm = gid * WGM, gsz = (nM - fm) < WGM ? (nM - fm) : WGM;
        u.pm = fm + ((wgid % nig) % gsz); u.pn = (wgid % nig) / gsz; return true;
    }
};

template <class Epi, class Sched>
__device__ __forceinline__ void gemm_phase(LAS unsigned char* lds, const Gemm g, const Sched& S, const Epi& E) {
    int tid_ = threadIdx.x; asm volatile("" : "+v"(tid_));
    const int tid = tid_, wid = __builtin_amdgcn_readfirstlane(tid >> 6), lane = tid & 63, wr = wid >> 2, wc = wid & 3, fr = lane & 15, fq = lane >> 4;
    int nt_ = g.K / BK; asm volatile("" : "+s"(nt_)); const int nt = nt_;
    unsigned voffA[2], voffB[2];
#pragma unroll
    for (int i = 0; i < 2; ++i) { int R, C; stage_rc(tid * 16 + i * 8192, R, C); const int Rb = (R & ~31) + perm32(R & 31);
        voffA[i] = (unsigned)(R * g.lda + C) * 2u; voffB[i] = (unsigned)(Rb * g.ldb + C) * 2u; }
    const size_t kstep = (size_t)(BK * 2);
    const size_t hA = (size_t)HALF * g.lda * 2, hB = (size_t)HALF * g.ldb * 2, tA = 2 * hA, tB = 2 * hB;
    const unsigned ldsw = (unsigned)wid * 1024u;
    const int aoff = lds_byte(wr * 64 + fr, fq * 8), boff = lds_byte(wc * 32 + fr, fq * 8);
#define PG8_SA(b, h) (((b) * 2 + (h)) * HTB)
#define PG8_SB(b, h) ((4 + (b) * 2 + (h)) * HTB)
#define PG8_STAGE(bufoff, gbase, voff) do { _Pragma("unroll") for (int _i = 0; _i < 2; ++_i) \
        __builtin_amdgcn_global_load_lds((const unsigned*)((const char*)(gbase) + (voff)[_i]), (LAS unsigned*)(lds + (bufoff) + ldsw + _i * 8192), 16, 0, 0); } while (0)
#define PG8_LDA(dst, b, h) do { _Pragma("unroll") for (int m = 0; m < 4; ++m) _Pragma("unroll") for (int k = 0; k < 2; ++k) dst[m][k] = *(const LAS bf16x8*)(lds + PG8_SA(b, h) + aoff + m * 2048 + k * 1024); } while (0)
#define PG8_LDB(dst, b, h) do { _Pragma("unroll") for (int n = 0; n < 2; ++n) _Pragma("unroll") for (int k = 0; k < 2; ++k) dst[n][k] = *(const LAS bf16x8*)(lds + PG8_SB(b, h) + boff + n * 2048 + k * 1024); } while (0)
#define PG8_MMA(ai, bj, At, Bt) do { __builtin_amdgcn_s_setprio(1); _Pragma("unroll") for (int m = 0; m < 4; ++m) _Pragma("unroll") for (int n = 0; n < 2; ++n) _Pragma("unroll") for (int k = 0; k < 2; ++k) \
        acc[ai][bj][m][n] = __builtin_amdgcn_mfma_f32_16x16x32_bf16(Bt[n][k], At[m][k], acc[ai][bj][m][n], 0, 0, 0); __builtin_amdgcn_s_setprio(0); } while (0)
#define PG8_WAIT_V(n) asm volatile("s_waitcnt vmcnt(" #n ")" ::: "memory")
#define PG8_WAIT_L(n) asm volatile("s_waitcnt lgkmcnt(" #n ")" ::: "memory")
#define PG8_BAR __builtin_amdgcn_s_barrier()
#define PG8_SCHED __builtin_amdgcn_sched_barrier(0)
    Unit cur, nxt; int ui = 0;
    if (!S.next(0, cur)) return;
    f32x4 acc[2][2][4][2];
#pragma unroll
    for (int a = 0; a < 2; ++a)
#pragma unroll
        for (int b = 0; b < 2; ++b)
#pragma unroll
            for (int m = 0; m < 4; ++m)
#pragma unroll
                for (int n = 0; n < 2; ++n) acc[a][b][m][n] = (f32x4){0.f, 0.f, 0.f, 0.f};
    bf16x8 At[4][2], B0[2][2], B1[2][2];
    const char* cA = (const char*)g.A + (size_t)cur.pm * tA; const char* cB = (const char*)g.Bt + (size_t)cur.pn * tB;
    PG8_STAGE(PG8_SB(0, 0), cB, voffB); PG8_STAGE(PG8_SB(0, 1), cB + hB, voffB); PG8_STAGE(PG8_SA(0, 0), cA, voffA); PG8_STAGE(PG8_SA(0, 1), cA + hA, voffA);
    if (wr == 1) PG8_BAR;
    PG8_WAIT_V(2); PG8_BAR;
    PG8_STAGE(PG8_SB(1, 0), cB + kstep, voffB); PG8_STAGE(PG8_SA(1, 0), cA + kstep, voffA); PG8_STAGE(PG8_SB(1, 1), cB + hB + kstep, voffB);
    PG8_WAIT_V(6); PG8_BAR;
    for (;;) {
        const bool has_next = S.next(ui + 1, nxt);
        const char* nA = has_next ? (const char*)g.A + (size_t)nxt.pm * tA : cA; const char* nB = has_next ? (const char*)g.Bt + (size_t)nxt.pn * tB : cB;
#pragma unroll 1
        for (int t = 0; t < nt; t += 2) {
            const bool last = (t == nt - 2);
            const char* a1 = cA + (size_t)(t + 1) * kstep;
            const char* a2 = last ? nA : cA + (size_t)(t + 2) * kstep; const char* b2 = last ? nB : cB + (size_t)(t + 2) * kstep;
            const char* a3 = a2 + kstep; const char* b3 = b2 + kstep;
            PG8_LDB(B0, 0, 0); PG8_LDB(B1, 0, 1); PG8_SCHED; PG8_LDA(At, 0, 0); PG8_STAGE(PG8_SA(1, 1), a1 + hA, voffA);
            PG8_WAIT_V(8); PG8_WAIT_L(0); PG8_BAR; PG8_MMA(0, 0, At, B0); PG8_MMA(0, 1, At, B1); PG8_BAR; PG8_SCHED;
            PG8_LDA(At, 0, 1); PG8_STAGE(PG8_SB(0, 0), b2, voffB); PG8_STAGE(PG8_SB(0, 1), b2 + hB, voffB); PG8_STAGE(PG8_SA(0, 0), a2, voffA);
            PG8_WAIT_V(8); PG8_WAIT_L(0); PG8_BAR; PG8_MMA(1, 0, At, B0); PG8_MMA(1, 1, At, B1); PG8_BAR; PG8_SCHED;
            PG8_LDB(B0, 1, 0); PG8_LDB(B1, 1, 1); PG8_SCHED; PG8_LDA(At, 1, 0); PG8_STAGE(PG8_SA(0, 1), a2 + hA, voffA);
            PG8_WAIT_V(8); PG8_WAIT_L(0); PG8_BAR; PG8_MMA(0, 0, At, B0); PG8_MMA(0, 1, At, B1); PG8_BAR; PG8_SCHED;
            PG8_LDA(At, 1, 1); PG8_STAGE(PG8_SB(1, 0), b3, voffB); PG8_STAGE(PG8_SB(1, 1), b3 + hB, voffB); PG8_STAGE(PG8_SA(1, 0), a3, voffA);
            PG8_WAIT_V(8); PG8_WAIT_L(0); PG8_BAR; PG8_MMA(1, 0, At, B0); PG8_MMA(1, 1, At, B1); PG8_BAR; PG8_SCHED;
        }
        if (wr == 0) PG8_BAR;
        E(acc, cur, wr, wc, fr, fq);
        if (!has_next) break;
#pragma unroll
        for (int a = 0; a < 2; ++a)
#pragma unroll
            for (int b = 0; b < 2; ++b)
#pragma unroll
                for (int m = 0; m < 4; ++m)
#pragma unroll
                    for (int n = 0; n < 2; ++n) acc[a][b][m][n] = (f32x4){0.f, 0.f, 0.f, 0.f};
        cur = nxt; cA = nA; cB = nB; ++ui;
        if (wr == 1) PG8_BAR;
    }
    PG8_WAIT_V(0);
    PG8_BAR;
#undef PG8_SA
#undef PG8_SB
#undef PG8_STAGE
#undef PG8_LDA
#undef PG8_LDB
#undef PG8_MMA
#undef PG8_WAIT_V
#undef PG8_WAIT_L
#undef PG8_BAR
#undef PG8_SCHED
}
}

typedef f32x4 Acc[2][2][4][2];

__device__ __forceinline__ float row_rx(const float* ssq, int row, int fq) {
    float s = sum4(*(const f32x4*)(ssq + (size_t)row * 16 + 4 * fq));
    s += __shfl_xor(s, 16); s += __shfl_xor(s, 32);
    return 1.0f / sqrtf(s * (1.0f / 1024.0f) + NORM_EPS);
}

struct EpiUp {
    bf16_t* O; const float* ssq;
    __device__ __forceinline__ void operator()(const Acc& acc, const pg8::Unit& u, int wr, int wc, int fr, int fq) const {
        const int row0 = u.pm * 256 + wr * 64 + fr, col0 = u.pn * 256 + wc * 32 + 8 * fq;
#pragma unroll
        for (int ai = 0; ai < 2; ++ai)
#pragma unroll
            for (int m = 0; m < 4; ++m) { const int row = row0 + ai * 128 + m * 16; const float r = row_rx(ssq, row, fq);
#pragma unroll
                for (int bj = 0; bj < 2; ++bj) { f32x4 v0 = acc[ai][bj][m][0] * r, v1 = acc[ai][bj][m][1] * r;
                    v0 = __builtin_elementwise_max(v0, (f32x4){0.f, 0.f, 0.f, 0.f}); v1 = __builtin_elementwise_max(v1, (f32x4){0.f, 0.f, 0.f, 0.f});
                    *(u32x4*)(O + (size_t)row * FF + col0 + bj * 128) = pack8(v0 * v0, v1 * v1); } asm volatile("" ::: "memory"); }
    }
};
struct EpiU {
    bf16_t* O; const float* ssq;
    __device__ __forceinline__ void operator()(const Acc& acc, const pg8::Unit& u, int wr, int wc, int fr, int fq) const {
        const int row0 = u.pm * 256 + wr * 64 + fr, col0 = u.pn * 256 + wc * 32 + 8 * fq;
#pragma unroll
        for (int ai = 0; ai < 2; ++ai)
#pragma unroll
            for (int m = 0; m < 4; ++m) { const int row = row0 + ai * 128 + m * 16; const float r = row_rx(ssq, row, fq);
#pragma unroll
                for (int bj = 0; bj < 2; ++bj) { const f32x4 v0 = gelu4(acc[ai][bj][m][0] * r), v1 = gelu4(acc[ai][bj][m][1] * r);
                    *(u32x4*)(O + (size_t)row * SGW + col0 + bj * 128) = pack8(v0, v1); } asm volatile("" ::: "memory"); }
    }
};
struct EpiRes {
    bf16_t* xb; float* ssq;
    __device__ __forceinline__ void operator()(const Acc& acc, const pg8::Unit& u, int wr, int wc, int fr, int fq) const {
        const int row0 = u.pm * 256 + wr * 64 + fr, col0 = u.pn * 256 + wc * 32 + 8 * fq;
#pragma unroll
        for (int ai = 0; ai < 2; ++ai)
#pragma unroll
            for (int m = 0; m < 4; ++m) { const int row = row0 + ai * 128 + m * 16; float s = 0.f;
#pragma unroll
                for (int bj = 0; bj < 2; ++bj) { const size_t p = (size_t)row * DM + col0 + bj * 128;
                    const u32x4 o = *(const u32x4*)(xb + p);
                    f32x4 x0, x1;
                    x0[0] = __builtin_bit_cast(float, o.x << 16); x0[1] = __builtin_bit_cast(float, o.x & 0xffff0000u); x0[2] = __builtin_bit_cast(float, o.y << 16); x0[3] = __builtin_bit_cast(float, o.y & 0xffff0000u);
                    x1[0] = __builtin_bit_cast(float, o.z << 16); x1[1] = __builtin_bit_cast(float, o.z & 0xffff0000u); x1[2] = __builtin_bit_cast(float, o.w << 16); x1[3] = __builtin_bit_cast(float, o.w & 0xffff0000u);
                    x0 += acc[ai][bj][m][0]; x1 += acc[ai][bj][m][1];
                    *(u32x4*)(xb + p) = pack8(x0, x1); s += dot4(x0) + dot4(x1); }
                s += __shfl_xor(s, 16); s += __shfl_xor(s, 32);
                if (fq == 0) ssq[(size_t)row * 16 + u.pn * 4 + wc] = s; asm volatile("" ::: "memory"); }
    }
};
struct EpiLat {
    bf16_t* lat; bf16_t* kr; const float* ssqx; float* ssqq; float* ssqkv; const float* cs; const float* sn;
    __device__ __forceinline__ void operator()(const Acc& acc, const pg8::Unit& u, int wr, int wc, int fr, int fq) const {
        const int row0 = u.pm * 256 + wr * 64 + fr;
#pragma unroll
        for (int ai = 0; ai < 2; ++ai)
#pragma unroll
            for (int m = 0; m < 4; ++m) { const int row = row0 + ai * 128 + m * 16; const float r = row_rx(ssqx, row, fq);
                const f32x4 a0 = acc[ai][0][m][0] * r, a1 = acc[ai][0][m][1] * r, b0 = acc[ai][1][m][0] * r, b1 = acc[ai][1][m][1] * r;
                if (u.pn == 0) {
                    bf16_t* o = lat + (size_t)row * LATK + wc * 32 + 8 * fq;
                    *(u32x4*)o = pack8(a0, a1); *(u32x4*)(o + 128) = pack8(b0, b1);
                    float s = dot4(a0) + dot4(a1) + dot4(b0) + dot4(b1); s += __shfl_xor(s, 16); s += __shfl_xor(s, 32);
                    if (fq == 0) ssqq[(size_t)row * 4 + wc] = s;
                } else if (wc < 2) {
                    bf16_t* o = lat + (size_t)row * LATK + 256 + wc * 32 + 8 * fq;
                    *(u32x4*)o = pack8(a0, a1); *(u32x4*)(o + 64) = pack8(b0, b1);
                    float s = dot4(a0) + dot4(a1) + dot4(b0) + dot4(b1); s += __shfl_xor(s, 16); s += __shfl_xor(s, 32);
                    if (fq == 0) { ssqkv[(size_t)row * 4 + wc] = s; ssqkv[(size_t)row * 4 + 2 + wc] = 0.f; }
                } else if (wc == 2) {
                    const float* cp = cs + (size_t)row * 32 + 8 * fq; const float* sp = sn + (size_t)row * 32 + 8 * fq;
                    const f32x4 c0 = *(const f32x4*)cp, c1 = *(const f32x4*)(cp + 4), s0 = *(const f32x4*)sp, s1 = *(const f32x4*)(sp + 4);
                    bf16_t* o = kr + (size_t)row * 64 + 8 * fq;
                    *(u32x4*)o = pack8(a0 * c0 - b0 * s0, a1 * c1 - b1 * s1);
                    *(u32x4*)(o + 32) = pack8(b0 * c0 + a0 * s0, b1 * c1 + a1 * s1);
                }
                asm volatile("" ::: "memory");
            }
    }
};
struct EpiQK {
    bf16_t* qn; bf16_t* qr; bf16_t* kn; const float* ssqq; const float* ssqkv; const float* cs; const float* sn;
    __device__ __forceinline__ void operator()(const Acc& acc, const pg8::Unit& u, int wr, int wc, int fr, int fq) const {
        const int row0 = u.pm * 256 + wr * 64 + fr;
#pragma unroll
        for (int ai = 0; ai < 2; ++ai)
#pragma unroll
            for (int m = 0; m < 4; ++m) { const int row = row0 + ai * 128 + m * 16;
                const bool isq = u.pn < 6;
                const float ss = sum4(*(const f32x4*)((isq ? ssqq : ssqkv) + (size_t)row * 4));
                const float r = (isq ? QSCALE : 1.0f) / sqrtf(ss * (isq ? (1.0f / 256.0f) : (1.0f / 128.0f)) + NORM_EPS);
                const f32x4 a0 = acc[ai][0][m][0] * r, a1 = acc[ai][0][m][1] * r, b0 = acc[ai][1][m][0] * r, b1 = acc[ai][1][m][1] * r;
                if (u.pn < 4) {
                    bf16_t* o = qn + (size_t)row * 1024 + u.pn * 256 + wc * 32 + 8 * fq;
                    *(u32x4*)o = pack8(a0, a1); *(u32x4*)(o + 128) = pack8(b0, b1);
                } else if (u.pn < 6) {
                    const float* cp = cs + (size_t)row * 32 + 8 * fq; const float* sp = sn + (size_t)row * 32 + 8 * fq;
                    const f32x4 c0 = *(const f32x4*)cp, c1 = *(const f32x4*)(cp + 4), s0 = *(const f32x4*)sp, s1 = *(const f32x4*)(sp + 4);
                    bf16_t* o = qr + (size_t)row * 512 + ((u.pn - 4) * 4 + wc) * 64 + 8 * fq;
                    *(u32x4*)o = pack8(a0 * c0 - b0 * s0, a1 * c1 - b1 * s1);
                    *(u32x4*)(o + 32) = pack8(b0 * c0 + a0 * s0, b1 * c1 + a1 * s1);
                } else {
                    bf16_t* o = kn + (size_t)row * 1024 + (u.pn - 6) * 256 + wc * 32 + 8 * fq;
                    *(u32x4*)o = pack8(a0, a1); *(u32x4*)(o + 128) = pack8(b0, b1);
                }
                asm volatile("" ::: "memory");
            }
    }
};
struct EpiVT {
    bf16_t* vt; const float* ssqkv;
    __device__ __forceinline__ void operator()(const Acc& acc, const pg8::Unit& u, int wr, int wc, int fr, int fq) const {
        const int lane = threadIdx.x & 63;
        const int tokb = u.pn * 256 + wc * 32 + 8 * fq;
        float rmine; { const int tok = tokb + (fr >> 3) * 128 + (fr & 7); rmine = 1.0f / sqrtf(sum4(*(const f32x4*)(ssqkv + (size_t)tok * 4)) * (1.0f / 128.0f) + NORM_EPS); }
        const int f0 = u.pm * 256 + wr * 64 + fr;
#pragma unroll
        for (int bj = 0; bj < 2; ++bj) {
            f32x4 r0, r1;
#pragma unroll
            for (int e = 0; e < 4; ++e) { r0[e] = __shfl(rmine, (lane & 48) | (bj * 8 + e)); r1[e] = __shfl(rmine, (lane & 48) | (bj * 8 + 4 + e)); }
            const int g16 = u.pn * 256 + bj * 128 + wc * 32 + (fq >> 1) * 16;
#pragma unroll
            for (int ai = 0; ai < 2; ++ai)
#pragma unroll
                for (int m = 0; m < 4; ++m) { const int f = f0 + ai * 128 + m * 16;
                    const f32x4 v0 = acc[ai][bj][m][0] * r0, v1 = acc[ai][bj][m][1] * r1;
                    bf16_t* o = vt + (size_t)f * M + g16 + 4 * (fq & 1);
                    u32x2 w0, w1; w0.x = cvt_pk_bf16(v0[0], v0[1]); w0.y = cvt_pk_bf16(v0[2], v0[3]); w1.x = cvt_pk_bf16(v1[0], v1[1]); w1.y = cvt_pk_bf16(v1[2], v1[3]);
                    *(u32x2*)o = w0; *(u32x2*)(o + 8) = w1; asm volatile("" ::: "memory"); }
        }
    }
};
struct EpiVTS {
    bf16_t* vt; const float* ssqx; float* lnst;
    __device__ __forceinline__ void operator()(const Acc& acc, const pg8::Unit& u, int wr, int wc, int fr, int fq) const {
        const int lane = threadIdx.x & 63;
        const int tokb = u.pn * 256 + wc * 32 + 8 * fq;
        float rmine; { const int tok = tokb + (fr >> 3) * 128 + (fr & 7); const float* p = ssqx + (size_t)tok * 16;
            const float s = (sum4(*(const f32x4*)p) + sum4(*(const f32x4*)(p + 4))) + (sum4(*(const f32x4*)(p + 8)) + sum4(*(const f32x4*)(p + 12)));
            rmine = 1.0f / sqrtf(s * (1.0f / 1024.0f) + NORM_EPS); }
        const int f0 = u.pm * 256 + wr * 64 + fr;
#pragma unroll
        for (int bj = 0; bj < 2; ++bj) {
            f32x4 r0, r1;
#pragma unroll
            for (int e = 0; e < 4; ++e) { r0[e] = __shfl(rmine, (lane & 48) | (bj * 8 + e)); r1[e] = __shfl(rmine, (lane & 48) | (bj * 8 + 4 + e)); }
            f32x4 s10 = {0.f, 0.f, 0.f, 0.f}, s11 = s10, s20 = s10, s21 = s10;
            const int tok0 = tokb + bj * 128;
#pragma unroll
            for (int ai = 0; ai < 2; ++ai)
#pragma unroll
                for (int m = 0; m < 4; ++m) { const int f = f0 + ai * 128 + m * 16;
                    const f32x4 v0 = gelu4(acc[ai][bj][m][0] * r0), v1 = gelu4(acc[ai][bj][m][1] * r1);
                    *(u32x4*)(vt + (size_t)f * M + tok0) = pack8(v0, v1);
                    s10 += v0; s11 += v1; s20 += v0 * v0; s21 += v1 * v1; asm volatile("" ::: "memory"); }
#pragma unroll
            for (int o = 1; o < 16; o <<= 1) {
#pragma unroll
                for (int e = 0; e < 4; ++e) { s10[e] += __shfl_xor(s10[e], o); s11[e] += __shfl_xor(s11[e], o); s20[e] += __shfl_xor(s20[e], o); s21[e] += __shfl_xor(s21[e], o); } }
            if (fr == 0) {
                const int slot = u.pm * 2 + wr;
#pragma unroll
                for (int e = 0; e < 4; ++e) {
                    *(f32x2*)(lnst + ((size_t)(tok0 + e) * 16 + slot) * 2) = (f32x2){s10[e], s20[e]};
                    *(f32x2*)(lnst + ((size_t)(tok0 + 4 + e) * 16 + slot) * 2) = (f32x2){s11[e], s21[e]}; }
            }
        }
    }
};

namespace att {
constexpr int KROW = 200, VROW = 72, KBYTES = 64 * KROW * 2, VBYTES = 128 * VROW * 2, BUFB = KBYTES + VBYTES;
__device__ __forceinline__ int crow(int r, int hi) { return (r & 3) + 8 * (r >> 2) + 4 * hi; }

__device__ __forceinline__ void attn_unit(LAS unsigned char* lds, int b, int h, int qb, const bf16_t* Qn, const bf16_t* Qr, const bf16_t* __restrict__ Kn,
                                          const bf16_t* __restrict__ Kr, const bf16_t* __restrict__ Vt, bf16_t* O) {
    int tid_ = threadIdx.x; asm volatile("" : "+v"(tid_));
    const int tid = tid_, lane = tid & 63, r32 = lane & 31, hi = lane >> 5, wid = __builtin_amdgcn_readfirstlane(tid >> 6);
    const int tok0 = b * SEQ, q0 = qb * 256;
    const int qtok = tok0 + q0 + wid * 32 + r32;
    bf16x8 qf[12];
#pragma unroll
    for (int ks = 0; ks < 8; ++ks) qf[ks] = *(const bf16x8*)(Qn + (size_t)qtok * 1024 + h * 128 + ks * 16 + hi * 8);
#pragma unroll
    for (int ks = 0; ks < 4; ++ks) qf[8 + ks] = *(const bf16x8*)(Qr + (size_t)qtok * 512 + h * 64 + ks * 16 + hi * 8);
    f32x16 o[4];
#pragma unroll
    for (int d = 0; d < 4; ++d)
#pragma unroll
        for (int r = 0; r < 16; ++r) o[d][r] = 0.f;
    float mrow = -INFINITY, lrow = 0.f;
    const int NT = 4 * (qb + 1);
    u32x4 st[5];
    const int krow0 = tid >> 4, kcc = tid & 15, rrow = tid >> 3, rcc = tid & 7;
    const bf16_t* kn_src = Kn + (size_t)(tok0 + krow0) * 1024 + h * 128 + kcc * 8;
    const bf16_t* kr_src = Kr + (size_t)(tok0 + rrow) * 64 + rcc * 8;
    const bf16_t* vt_src = Vt + (size_t)(h * 128 + rrow) * M + tok0 + rcc * 8;
#define ATT_LOAD(j) do { const size_t tb_ = (size_t)(j) * 64; \
        st[0] = *(const u32x4*)(kn_src + tb_ * 1024); st[1] = *(const u32x4*)(kn_src + (tb_ + 32) * 1024); \
        st[2] = *(const u32x4*)(kr_src + tb_ * 64); \
        st[3] = *(const u32x4*)(vt_src + tb_); st[4] = *(const u32x4*)(vt_src + (size_t)64 * M + tb_); } while (0)
#define ATT_STORE(buf) do { LAS unsigned char* ks_ = lds + (buf) * BUFB; LAS unsigned char* vs_ = ks_ + KBYTES; \
        *(LAS u32x4*)(ks_ + (krow0 * KROW + kcc * 8) * 2) = st[0]; *(LAS u32x4*)(ks_ + ((krow0 + 32) * KROW + kcc * 8) * 2) = st[1]; \
        *(LAS u32x4*)(ks_ + (rrow * KROW + 128 + rcc * 8) * 2) = st[2]; \
        *(LAS u32x4*)(vs_ + (rrow * VROW + rcc * 8) * 2) = st[3]; *(LAS u32x4*)(vs_ + ((rrow + 64) * VROW + rcc * 8) * 2) = st[4]; } while (0)
    ATT_LOAD(0);
    for (int j = 0; j < NT; ++j) {
        const int buf = j & 1;
        ATT_STORE(buf);
        __syncthreads();
        if (j + 1 < NT) ATT_LOAD(j + 1);
        const LAS unsigned char* kp = lds + buf * BUFB + (r32 * KROW + hi * 8) * 2;
        const LAS unsigned char* vp = lds + buf * BUFB + KBYTES + (r32 * VROW + hi * 8) * 2;
        f32x16 p0, p1;
#pragma unroll
        for (int r = 0; r < 16; ++r) { p0[r] = 0.f; p1[r] = 0.f; }
#pragma unroll
        for (int ks = 0; ks < 12; ++ks) {
            const bf16x8 a0 = *(const LAS bf16x8*)(kp + ks * 32), a1 = *(const LAS bf16x8*)(kp + 32 * KROW * 2 + ks * 32);
            p0 = __builtin_amdgcn_mfma_f32_32x32x16_bf16(a0, qf[ks], p0, 0, 0, 0);
            p1 = __builtin_amdgcn_mfma_f32_32x32x16_bf16(a1, qf[ks], p1, 0, 0, 0);
        }
        const int jb = j - (NT - 4);
        if (jb >= 0 && 64 * jb + 63 > wid * 32) {
            const int qrel = wid * 32 + r32, kb = 64 * jb + 4 * hi;
#pragma unroll
            for (int r = 0; r < 16; ++r) { const int kv = kb + (r & 3) + 8 * (r >> 2); if (kv > qrel) p0[r] = -INFINITY; if (kv + 32 > qrel) p1[r] = -INFINITY; }
        }
        float mx = fmaxf(p0[0], p1[0]);
#pragma unroll
        for (int r = 1; r < 16; ++r) mx = fmaxf(mx, fmaxf(p0[r], p1[r]));
        mx = fmaxf(mx, __shfl_xor(mx, 32));
        const float mnew = fmaxf(mrow, mx);
        const float alpha = __builtin_amdgcn_exp2f(mrow - mnew);
        mrow = mnew;
        float ls = 0.f;
#pragma unroll
        for (int r = 0; r < 16; ++r) { p0[r] = __builtin_amdgcn_exp2f(p0[r] - mnew); p1[r] = __builtin_amdgcn_exp2f(p1[r] - mnew); ls += p0[r] + p1[r]; }
        lrow = lrow * alpha + ls;
#pragma unroll
        for (int d = 0; d < 4; ++d)
#pragma unroll
            for (int r = 0; r < 16; ++r) o[d][r] *= alpha;
        bf16x8 pk[4];
        { u32x4 w;
          w.x = cvt_pk_bf16(p0[0], p0[1]); w.y = cvt_pk_bf16(p0[2], p0[3]); w.z = cvt_pk_bf16(p0[4], p0[5]); w.w = cvt_pk_bf16(p0[6], p0[7]); pk[0] = __builtin_bit_cast(bf16x8, w);
          w.x = cvt_pk_bf16(p0[8], p0[9]); w.y = cvt_pk_bf16(p0[10], p0[11]); w.z = cvt_pk_bf16(p0[12], p0[13]); w.w = cvt_pk_bf16(p0[14], p0[15]); pk[1] = __builtin_bit_cast(bf16x8, w);
          w.x = cvt_pk_bf16(p1[0], p1[1]); w.y = cvt_pk_bf16(p1[2], p1[3]); w.z = cvt_pk_bf16(p1[4], p1[5]); w.w = cvt_pk_bf16(p1[6], p1[7]); pk[2] = __builtin_bit_cast(bf16x8, w);
          w.x = cvt_pk_bf16(p1[8], p1[9]); w.y = cvt_pk_bf16(p1[10], p1[11]); w.z = cvt_pk_bf16(p1[12], p1[13]); w.w = cvt_pk_bf16(p1[14], p1[15]); pk[3] = __builtin_bit_cast(bf16x8, w); }
#pragma unroll
        for (int d = 0; d < 4; ++d)
#pragma unroll
            for (int ks = 0; ks < 4; ++ks) {
                const bf16x8 a = *(const LAS bf16x8*)(vp + d * 32 * VROW * 2 + ks * 32);
                o[d] = __builtin_amdgcn_mfma_f32_32x32x16_bf16(a, pk[ks], o[d], 0, 0, 0);
            }
    }
#undef ATT_LOAD
#undef ATT_STORE
    const float ltot = lrow + __shfl_xor(lrow, 32);
    const float inv = 1.0f / ltot;
    bf16_t* op = O + (size_t)qtok * 1024 + h * 128 + 4 * hi;
#pragma unroll
    for (int d = 0; d < 4; ++d)
#pragma unroll
        for (int rg = 0; rg < 4; ++rg) { u32x2 w; w.x = cvt_pk_bf16(o[d][4 * rg] * inv, o[d][4 * rg + 1] * inv); w.y = cvt_pk_bf16(o[d][4 * rg + 2] * inv, o[d][4 * rg + 3] * inv);
            *(u32x2*)(op + 32 * d + 8 * rg) = w; }
}
}

namespace sgu {
constexpr int AROW = 136;
constexpr int A_BYTES = 256 * AROW * 2, B_BYTES = 128 * AROW * 2, ST_OFF = A_BYTES + B_BYTES;
__device__ __forceinline__ void item(LAS unsigned char* lds, int c, int g, const bf16_t* __restrict__ vT, const float* __restrict__ lnst, const float* __restrict__ lng,
                                     const float* __restrict__ lnb, const bf16_t* __restrict__ wsp, const float* __restrict__ bsp, bf16_t* U) {
    int tid_ = threadIdx.x; asm volatile("" : "+v"(tid_));
    const int tid = tid_, lane = tid & 63, r32 = lane & 31, hi = lane >> 5, wid = __builtin_amdgcn_readfirstlane(tid >> 6);
    const int tokbase = c * 128;
    LAS float* mu = (LAS float*)(lds + ST_OFF); LAS float* rs = mu + 128;
    if (tid < 128) {
        const float* p = lnst + (size_t)(tokbase + tid) * 32; float s1 = 0.f, s2 = 0.f;
#pragma unroll
        for (int i = 0; i < 8; ++i) { const f32x4 v = *(const f32x4*)(p + 4 * i); s1 += v[0] + v[2]; s2 += v[1] + v[3]; }
        const float mean = s1 * (1.0f / 2048.0f), var = fmaxf(s2 * (1.0f / 2048.0f) - mean * mean, 0.f);
        mu[tid] = mean; rs[tid] = 1.0f / sqrtf(var + LN_EPS);
    }
#pragma unroll
    for (int i = 0; i < 4; ++i) { const int ch = tid + 512 * i, t = ch >> 4, cc = ch & 15;
        *(LAS u32x4*)(lds + A_BYTES + (t * AROW + cc * 8) * 2) = *(const u32x4*)(wsp + ((size_t)g * 128 + t) * 128 + cc * 8); }
    __syncthreads();
#pragma unroll
    for (int i = 0; i < 8; ++i) { const int ch = tid + 512 * i, d = ch >> 4, cc = ch & 15;
        const u32x4 raw = *(const u32x4*)(vT + (size_t)(g * 256 + d) * M + tokbase + cc * 8);
        const float gg = lng[g * 256 + d], bb = lnb[g * 256 + d];
        float v[8];
#pragma unroll
        for (int e = 0; e < 4; ++e) { const unsigned w = raw[e]; v[2 * e] = __builtin_bit_cast(float, w << 16); v[2 * e + 1] = __builtin_bit_cast(float, w & 0xffff0000u); }
#pragma unroll
        for (int e = 0; e < 8; ++e) { const int s = cc * 8 + e; v[e] = (v[e] - mu[s]) * rs[s] * gg + bb; }
        u32x4 w; w.x = cvt_pk_bf16(v[0], v[1]); w.y = cvt_pk_bf16(v[2], v[3]); w.z = cvt_pk_bf16(v[4], v[5]); w.w = cvt_pk_bf16(v[6], v[7]);
        *(LAS u32x4*)(lds + (d * AROW + cc * 8) * 2) = w; }
    __syncthreads();
    f32x16 acc[4];
#pragma unroll
    for (int tb = 0; tb < 4; ++tb)
#pragma unroll
        for (int r = 0; r < 16; ++r) acc[tb][r] = 0.f;
    const LAS unsigned char* ap = lds + ((wid * 32 + r32) * AROW + hi * 8) * 2;
    const LAS unsigned char* bp = lds + A_BYTES + (r32 * AROW + hi * 8) * 2;
#pragma unroll
    for (int ks = 0; ks < 8; ++ks) {
        const bf16x8 a = *(const LAS bf16x8*)(ap + ks * 32);
#pragma unroll
        for (int tb = 0; tb < 4; ++tb) if (16 * ks <= 32 * tb + 31) {
            const bf16x8 bq = *(const LAS bf16x8*)(bp + tb * 32 * AROW * 2 + ks * 32);
            acc[tb] = __builtin_amdgcn_mfma_f32_32x32x16_bf16(a, bq, acc[tb], 0, 0, 0);
        }
    }
#pragma unroll
    for (int tb = 0; tb < 4; ++tb) { const int t = tb * 32 + r32; const float bias = bsp[g * 128 + t];
        bf16_t* up = U + (size_t)(tokbase + t) * SGW + g * 256 + wid * 32 + 4 * hi;
#pragma unroll
        for (int rg = 0; rg < 4; ++rg) { const u32x2 uu = *(const u32x2*)(up + 8 * rg);
            const float u0 = __builtin_bit_cast(float, uu.x << 16), u1 = __builtin_bit_cast(float, uu.x & 0xffff0000u), u2 = __builtin_bit_cast(float, uu.y << 16), u3 = __builtin_bit_cast(float, uu.y & 0xffff0000u);
            u32x2 w; w.x = cvt_pk_bf16(u0 * (acc[tb][4 * rg] + bias), u1 * (acc[tb][4 * rg + 1] + bias)); w.y = cvt_pk_bf16(u2 * (acc[tb][4 * rg + 2] + bias), u3 * (acc[tb][4 * rg + 3] + bias));
            *(u32x2*)(up + 8 * rg) = w; } }
    __syncthreads();
}
}

__device__ __forceinline__ float wave_sum(float v) {
#pragma unroll
    for (int o = 1; o < 64; o <<= 1) v += __shfl_xor(v, o);
    return v;
}
template <class F>
__device__ __forceinline__ void conv_matrix(const F& f, bf16_t* WT, int Kd, int Nd, LAS float* scr, int gw, int NGW, int lane_) {
    (void)lane_; int lt_ = threadIdx.x; asm volatile("" : "+v"(lt_)); const int lane = lt_ & 63;
    const int nblk = Nd / 32, nitems = (Kd / 64) * nblk;
    for (int it = gw; it < nitems; it += NGW) {
        const int kb = it / nblk, nb = it % nblk, k0 = 64 * kb, n0 = 32 * nb;
#pragma unroll
        for (int i = 0; i < 32; ++i) { const int kk = 2 * i + (lane >> 5); scr[kk * 33 + (lane & 31)] = f(k0 + kk, n0 + (lane & 31)); }
        asm volatile("s_waitcnt lgkmcnt(0)" ::: "memory");
        const int c = lane & 7;
#pragma unroll
        for (int j = 0; j < 4; ++j) { const int n = (lane >> 3) + 8 * j; const LAS float* s = scr + (8 * c) * 33 + n;
            u32x4 o; o.x = cvt_pk_bf16(s[0 * 33], s[1 * 33]); o.y = cvt_pk_bf16(s[2 * 33], s[3 * 33]); o.z = cvt_pk_bf16(s[4 * 33], s[5 * 33]); o.w = cvt_pk_bf16(s[6 * 33], s[7 * 33]);
            *(u32x4*)(WT + (size_t)(n0 + n) * Kd + k0 + 8 * c) = o; }
        asm volatile("s_waitcnt lgkmcnt(0)" ::: "memory");
    }
}

struct Args {
    const float* x; const int* pos; const float* norm_mix; const float* norm_ffn; const float* final_norm;
    const float* w_dkv; const float* q_norm; const float* kv_norm; const float* w_uq; const float* w_ukv; const float* w_o;
    const float* w_in; const float* ln_g; const float* ln_b; const float* w_sp; const float* b_sp; const float* w_out;
    const float* w_up; const float* w_down;
    float* out; unsigned char* ws;
};

__device__ __forceinline__ void conv_set_a(const Args& a, int j, LAS float* scr, int gw, int NGW, int lane) {
    const int L = 2 * j;
    unsigned char* wa = a.ws + WS_WA;
    { const float* W = a.w_dkv + (size_t)j * 1024 * 448; const float* g = a.norm_mix + L * 1024;
      auto f = [=](int k, int n) -> float { int c;
          if (n < 256) c = n; else { const int l = n - 256, h2 = l >> 7, ll = l & 127; c = ll < 64 ? 256 + h2 * 64 + ll : (ll < 96 ? 384 + h2 * 32 + (ll - 64) : -1); }
          return c < 0 ? 0.f : W[(size_t)k * 448 + c] * g[k]; };
      conv_matrix(f, (bf16_t*)(wa + WA_LAT), 1024, 512, scr, gw, NGW, lane); }
    { const float* Wq = a.w_uq + (size_t)j * 256 * 1536; const float* Wkv = a.w_ukv + (size_t)j * 128 * 2048; const float* gq = a.q_norm + j * 256; const float* gk = a.kv_norm + j * 128;
      auto f = [=](int k, int n) -> float {
          if (n < 1536) { if (k >= 256) return 0.f; int c;
              if (n < 1024) c = (n >> 7) * 192 + (n & 127); else { const int l = n - 1024, uu = l >> 8, ll = l & 255, half = ll >> 7, hh = (ll & 127) >> 5, jj = ll & 31; c = (uu * 4 + hh) * 192 + 128 + half * 32 + jj; }
              return Wq[(size_t)k * 1536 + c] * gq[k]; }
          if (k < 256) return 0.f; const int l = n - 1536; return Wkv[(size_t)(k - 256) * 2048 + (l >> 7) * 256 + (l & 127)] * gk[k - 256]; };
      conv_matrix(f, (bf16_t*)(wa + WA_QK), LATK, 2560, scr, gw, NGW, lane); }
    { const float* Wkv = a.w_ukv + (size_t)j * 128 * 2048; const float* gk = a.kv_norm + j * 128;
      auto f = [=](int k, int n) -> float { if (k < 256) return 0.f; return Wkv[(size_t)(k - 256) * 2048 + (n >> 7) * 256 + 128 + (n & 127)] * gk[k - 256]; };
      conv_matrix(f, (bf16_t*)(wa + WA_V), LATK, 1024, scr, gw, NGW, lane); }
    { const float* W = a.w_o + (size_t)j * 1024 * 1024;
      auto f = [=](int k, int n) -> float { return W[(size_t)k * 1024 + n]; };
      conv_matrix(f, (bf16_t*)(wa + WA_O), 1024, 1024, scr, gw, NGW, lane); }
    { const float* W = a.w_up + (size_t)L * 1024 * 4096; const float* g = a.norm_ffn + L * 1024;
      auto f = [=](int k, int n) -> float { return W[(size_t)k * 4096 + n] * g[k]; };
      conv_matrix(f, (bf16_t*)(wa + WA_UP), 1024, 4096, scr, gw, NGW, lane); }
    { const float* W = a.w_down + (size_t)L * 4096 * 1024;
      auto f = [=](int k, int n) -> float { return W[(size_t)k * 1024 + n]; };
      conv_matrix(f, (bf16_t*)(wa + WA_DN), 4096, 1024, scr, gw, NGW, lane); }
}
__device__ __forceinline__ void conv_set_b(const Args& a, int j, LAS float* scr, int gw, int NGW, int lane) {
    const int L = 2 * j + 1;
    unsigned char* wb = a.ws + WS_WB;
    { const float* W = a.w_in + (size_t)j * 1024 * 4096; const float* g = a.norm_mix + L * 1024;
      auto f = [=](int k, int n) -> float { return W[(size_t)k * 4096 + n] * g[k]; };
      conv_matrix(f, (bf16_t*)(wb + WB_INU), 1024, 2048, scr, gw, NGW, lane);
      auto f2 = [=](int k, int n) -> float { return W[(size_t)k * 4096 + 2048 + n] * g[k]; };
      conv_matrix(f2, (bf16_t*)(wb + WB_INV), 1024, 2048, scr, gw, NGW, lane); }
    { const float* W = a.w_out + (size_t)j * 2048 * 1024;
      auto f = [=](int k, int n) -> float { return W[(size_t)k * 1024 + n]; };
      conv_matrix(f, (bf16_t*)(wb + WB_OUT), 2048, 1024, scr, gw, NGW, lane); }
    { const float* W = a.w_up + (size_t)L * 1024 * 4096; const float* g = a.norm_ffn + L * 1024;
      auto f = [=](int k, int n) -> float { return W[(size_t)k * 4096 + n] * g[k]; };
      conv_matrix(f, (bf16_t*)(wb + WB_UP), 1024, 4096, scr, gw, NGW, lane); }
    { const float* W = a.w_down + (size_t)L * 4096 * 1024;
      auto f = [=](int k, int n) -> float { return W[(size_t)k * 1024 + n]; };
      conv_matrix(f, (bf16_t*)(wb + WB_DN), 4096, 1024, scr, gw, NGW, lane); }
}


#define XB_TMO      128
#define XB_XCNT(j)  (256  + 64 * (j))
#define XB_XSUB(j)  (1280 + 64 * (j))
#define XB_XGEN(j)  (2304 + 64 * (j))
#define XB_TOP      3328
#define XB_TOPGEN   3392
#define XCD_BAR_WORDS 3456
#define XB_SPIN_CAP (1u << 22)
__device__ __forceinline__ unsigned xb_ld(unsigned* p)              { return __hip_atomic_load(p, __ATOMIC_RELAXED, __HIP_MEMORY_SCOPE_AGENT); }
__device__ __forceinline__ unsigned xb_add(unsigned* p, unsigned v) { return __hip_atomic_fetch_add(p, v, __ATOMIC_RELAXED, __HIP_MEMORY_SCOPE_AGENT); }
__device__ __forceinline__ unsigned xb_xcc_id() { return (unsigned)__builtin_amdgcn_s_getreg((3 << 11) | 20) & 0xFu; }
#define XB_SPIN(cond, bar) do { unsigned _sp = 0; while (cond) { __builtin_amdgcn_s_sleep(1); \
    if ((++_sp & 255u) == 0u) { if (xb_ld(&(bar)[XB_TMO])) break; if (_sp > XB_SPIN_CAP) { atomicAdd(&(bar)[XB_TMO], 1u); break; } } } } while (0)
struct XcdBarrier { unsigned* bar; unsigned x; volatile LAS unsigned* st; };
__device__ __forceinline__ XcdBarrier xcd_barrier_post(unsigned* bar, volatile LAS unsigned* st) {
    XcdBarrier b; b.bar = bar; b.x = xb_xcc_id(); b.st = st;
    if (threadIdx.x == 0) (void)xb_add(&bar[XB_XCNT(b.x)], 1u);
    return b;
}
__device__ __forceinline__ void xcd_barrier_complete(unsigned* bar, unsigned x, unsigned& nloc, unsigned& nx) {
    const unsigned G = gridDim.x * gridDim.y * gridDim.z;
    unsigned sum, cnt, mine, sp = 0u;
    for (;;) {
        sum = 0u; cnt = 0u; mine = 0u;
#pragma unroll
        for (unsigned j = 0; j < 16; ++j) { const unsigned c = xb_ld(&bar[XB_XCNT(j)]); sum += c; cnt += (c > 0u) ? 1u : 0u; mine = (j == x) ? c : mine; }
        if (sum == G) break;
        __builtin_amdgcn_s_sleep(1);
        if ((++sp & 255u) == 0u) { if (xb_ld(&bar[XB_TMO])) break; if (sp > XB_SPIN_CAP) { atomicAdd(&bar[XB_TMO], 1u); break; } }
    }
    nloc = mine > 0u ? mine : 1u; nx = cnt > 0u ? cnt : 1u;
}
__device__ __forceinline__ void xcd_barrier(const XcdBarrier& b) {
    asm volatile("s_waitcnt vmcnt(0)" ::: "memory");
    __syncthreads();
    if (threadIdx.x == 0) {
        unsigned* bar = b.bar;
        __builtin_amdgcn_s_waitcnt(0);
        unsigned nloc = b.st[0], nx = b.st[1];
        if (nloc == 0u) { xcd_barrier_complete(bar, b.x, nloc, nx); b.st[0] = nloc; b.st[1] = nx; }
        const unsigned old = xb_add(&bar[XB_XSUB(b.x)], 1u);
        const unsigned gen = old / nloc;
        if (old + 1u == (gen + 1u) * nloc) {
            __builtin_amdgcn_fence(__ATOMIC_RELEASE, "agent");
            asm volatile("s_waitcnt vmcnt(0)" ::: "memory");
            const unsigned og = xb_add(&bar[XB_TOP], 1u);
            const unsigned tg = og / nx;
            if (og + 1u == (tg + 1u) * nx) xb_add(&bar[XB_TOPGEN], 1u);
            else XB_SPIN(xb_ld(&bar[XB_TOPGEN]) == tg, bar);
            __builtin_amdgcn_fence(__ATOMIC_ACQUIRE, "agent");
            xb_add(&bar[XB_XGEN(b.x)], 1u);
            asm volatile("s_waitcnt vmcnt(0)" ::: "memory");
        } else {
            XB_SPIN(xb_ld(&bar[XB_XGEN(b.x)]) == gen, bar);
            __builtin_amdgcn_fence(__ATOMIC_ACQUIRE, "agent");
            asm volatile("s_waitcnt vmcnt(0)" ::: "memory");
        }
    }
    __syncthreads();
}

__global__ void __launch_bounds__(512, 2) mega_fwd(Args a) {
    extern __shared__ __attribute__((aligned(16))) unsigned char lds_raw[];
    LAS unsigned char* lds = (LAS unsigned char*)lds_raw;
    cg::grid_group grid = cg::this_grid();
    const int tid = threadIdx.x, lane = tid & 63, wave = __builtin_amdgcn_readfirstlane(tid >> 6);
    const int G = gridDim.x, bx = blockIdx.x;
    const int gw = bx * 8 + wave, NGW = G * 8;
    unsigned char* ws = a.ws;
    float* ssqx = (float*)(ws + WS_SSQX); float* ssqq = (float*)(ws + WS_SSQQ); float* ssqkv = (float*)(ws + WS_SSQKV); float* lnst = (float*)(ws + WS_LNST);
    float* cst = (float*)(ws + WS_COS); float* snt = (float*)(ws + WS_SIN);
    bf16_t* KR = (bf16_t*)(ws + WS_KR); bf16_t* WSP = (bf16_t*)(ws + WS_WSP);
    bf16_t* XB = (bf16_t*)(ws + WS_XB);
    unsigned char* hb = ws + WS_HB; unsigned char* wa = ws + WS_WA; unsigned char* wb = ws + WS_WB;
    bf16_t* HB = (bf16_t*)hb;
    bf16_t* LAT = (bf16_t*)(hb + HB_LAT); bf16_t* QN = (bf16_t*)(hb + HB_QN); bf16_t* QR = (bf16_t*)(hb + HB_QR); bf16_t* KN = (bf16_t*)(hb + HB_KN); bf16_t* VT = (bf16_t*)(hb + HB_VT);
    bf16_t* UB = (bf16_t*)(hb + HB_U); bf16_t* VTS = (bf16_t*)(hb + HB_VTS);
    float* X32 = a.out;
    LAS float* scr = (LAS float*)(lds + wave * 16384);
    volatile LAS unsigned* MISC = (volatile LAS unsigned*)(lds + 131072);
    if (tid < 64) MISC[tid] = 0u;
    unsigned* ctl = (unsigned*)(ws + WS_CTL);
    if (bx == 0) for (int i = tid; i < XCD_BAR_WORDS; i += 512) __hip_atomic_store(ctl + i, 0u, __ATOMIC_RELAXED, __HIP_MEMORY_SCOPE_AGENT);
    __syncthreads();

    conv_set_a(a, 0, scr, gw, NGW, lane);
    conv_set_b(a, 0, scr, gw, NGW, lane);
    for (int i = gw * 64 + lane; i < 2 * 8 * 128 * 128; i += NGW * 64) { const int s = i & 127, t = (i >> 7) & 127; WSP[i] = (bf16_t)(cvt_pk_bf16(s <= t ? a.w_sp[i] : 0.f, 0.f) & 0xffffu); }
    for (int i = gw * 64 + lane; i < M * 32; i += NGW * 64) { const int tok = i >> 5, fi = i & 31;
        const float inv_freq = exp2f(-(float)(2 * fi) * (13.287712379549449f / 64.0f));
        const float ang = (float)a.pos[tok] * inv_freq;
        const double rev = (double)ang * 0.15915494309189535; const float fr = (float)(rev - __builtin_rint(rev));
        cst[i] = __builtin_amdgcn_cosf(fr); snt[i] = __builtin_amdgcn_sinf(fr); }
    for (int m = gw; m < M; m += NGW) {
        const f32x4* xr = (const f32x4*)(a.x + (size_t)m * DM) + lane;
#pragma unroll
        for (int jj = 0; jj < 4; ++jj) { const f32x4 v = xr[64 * jj]; float s = dot4(v);
            u32x2 w; w.x = cvt_pk_bf16(v[0], v[1]); w.y = cvt_pk_bf16(v[2], v[3]);
            *(u32x2*)(XB + (size_t)m * DM + 256 * jj + 4 * lane) = w;
            s += __shfl_xor(s, 1); s += __shfl_xor(s, 2); s += __shfl_xor(s, 4); s += __shfl_xor(s, 8);
            if ((lane & 15) == 0) ssqx[(size_t)m * 16 + 4 * jj + (lane >> 4)] = s; }
    }
    grid.sync();
    const XcdBarrier xbar = xcd_barrier_post(ctl, MISC + 8);

    for (int L = 0; L < 4; ++L) {
        const int j = L >> 1;
        if ((L & 1) == 0) {
            { pg8::Gemm g{XB, (const bf16_t*)(wa + WA_LAT), M, 512, 1024, 1024, 1024}; pg8::StaticOrder S; S.init(M, 512, G, bx);
              EpiLat E{LAT, KR, ssqx, ssqq, ssqkv, cst, snt};
              pg8::gemm_phase(lds, g, S, E); }
            xcd_barrier(xbar);
            { pg8::Gemm g{LAT, (const bf16_t*)(wa + WA_QK), M, 2560, LATK, LATK, LATK}; pg8::StaticOrder S; S.init(M, 2560, G, bx);
              EpiQK E{QN, QR, KN, ssqq, ssqkv, cst, snt};
              pg8::gemm_phase(lds, g, S, E); }
            { pg8::Gemm g{(const bf16_t*)(wa + WA_V), LAT, 1024, M, LATK, LATK, LATK}; pg8::StaticOrder S; S.init(1024, M, G, bx);
              EpiVT E{VT, ssqkv};
              pg8::gemm_phase(lds, g, S, E); }
            xcd_barrier(xbar);
            { const int nsl = (G == 256) ? 1 : 0;
              for (int p0 = bx; p0 < 256; p0 += G) {
                  const int p = nsl ? ((p0 & 7) * 32 + (p0 >> 3)) : p0;
                  const int bh = p >> 3, pi = p & 7;
                  att::attn_unit(lds, bh >> 3, bh & 7, 15 - pi, QN, QR, KN, KR, VT, QN);
                  att::attn_unit(lds, bh >> 3, bh & 7, pi, QN, QR, KN, KR, VT, QN);
              }
              __syncthreads(); }
            if (L == 2) conv_set_b(a, 1, scr, gw, NGW, lane);
            xcd_barrier(xbar);
            { pg8::Gemm g{QN, (const bf16_t*)(wa + WA_O), M, 1024, 1024, 1024, 1024}; pg8::StaticOrder S; S.init(M, 1024, G, bx);
              EpiRes E{XB, ssqx};
              pg8::gemm_phase(lds, g, S, E); }
            xcd_barrier(xbar);
        } else {
            { pg8::Gemm g{XB, (const bf16_t*)(wb + WB_INU), M, SGW, 1024, 1024, 1024}; pg8::StaticOrder S; S.init(M, SGW, G, bx);
              EpiU E{UB, ssqx};
              pg8::gemm_phase(lds, g, S, E); }
            { pg8::Gemm g{(const bf16_t*)(wb + WB_INV), XB, SGW, M, 1024, 1024, 1024}; pg8::StaticOrder S; S.init(SGW, M, G, bx);
              EpiVTS E{VTS, ssqx, lnst};
              pg8::gemm_phase(lds, g, S, E); }
            xcd_barrier(xbar);
            { const bf16_t* wsp = WSP + (size_t)j * 8 * 128 * 128; const float* bsp = a.b_sp + j * 8 * 128;
              for (int it = bx; it < 1024; it += G) sgu::item(lds, it >> 3, it & 7, VTS, lnst, a.ln_g + j * SGW, a.ln_b + j * SGW, wsp, bsp, UB); }
            if (L == 1) conv_set_a(a, 1, scr, gw, NGW, lane);
            xcd_barrier(xbar);
            { pg8::Gemm g{UB, (const bf16_t*)(wb + WB_OUT), M, 1024, SGW, SGW, SGW}; pg8::StaticOrder S; S.init(M, 1024, G, bx);
              EpiRes E{XB, ssqx};
              pg8::gemm_phase(lds, g, S, E); }
            xcd_barrier(xbar);
        }
        unsigned char* wl = (L & 1) ? wb : wa;
        const size_t off_up = (L & 1) ? WB_UP : WA_UP, off_dn = (L & 1) ? WB_DN : WA_DN;
        { pg8::Gemm g{XB, (const bf16_t*)(wl + off_up), M, FF, 1024, 1024, 1024}; pg8::StaticOrder S; S.init(M, FF, G, bx);
          EpiUp E{HB, ssqx};
          pg8::gemm_phase(lds, g, S, E); }
        xcd_barrier(xbar);
        { pg8::Gemm g{HB, (const bf16_t*)(wl + off_dn), M, 1024, FF, FF, FF}; pg8::StaticOrder S; S.init(M, 1024, G, bx);
          EpiRes E{XB, ssqx};
          pg8::gemm_phase(lds, g, S, E); }
        xcd_barrier(xbar);
    }
    int lt2_ = threadIdx.x; asm volatile("" : "+v"(lt2_)); const int lane2 = lt2_ & 63;
    for (int m = gw; m < M; m += NGW) {
        const u32x4* xr = (const u32x4*)(XB + (size_t)m * DM) + lane2;
        float v[16]; float s = 0.f;
#pragma unroll
        for (int jj = 0; jj < 2; ++jj) { const u32x4 o = xr[64 * jj];
#pragma unroll
            for (int e = 0; e < 4; ++e) { v[8 * jj + 2 * e] = __builtin_bit_cast(float, o[e] << 16); v[8 * jj + 2 * e + 1] = __builtin_bit_cast(float, o[e] & 0xffff0000u); } }
#pragma unroll
        for (int e = 0; e < 16; ++e) s += v[e] * v[e];
        const float r = 1.0f / sqrtf(wave_sum(s) * (1.0f / 1024.0f) + NORM_EPS);
#pragma unroll
        for (int jj = 0; jj < 2; ++jj) { const int c0 = 512 * jj + 8 * lane2; const f32x4 g0 = *(const f32x4*)(a.final_norm + c0), g1 = *(const f32x4*)(a.final_norm + c0 + 4);
            float* op = X32 + (size_t)m * DM + c0;
            *(f32x4*)op = (f32x4){v[8 * jj] * r * g0[0], v[8 * jj + 1] * r * g0[1], v[8 * jj + 2] * r * g0[2], v[8 * jj + 3] * r * g0[3]};
            *(f32x4*)(op + 4) = (f32x4){v[8 * jj + 4] * r * g1[0], v[8 * jj + 5] * r * g1[1], v[8 * jj + 6] * r * g1[2], v[8 * jj + 7] * r * g1[3]}; }
    }
}

extern "C" void kernel_launch(void* const* d_in, const int* in_sizes, int n_in, void* d_out, int out_size, void* d_ws, size_t ws_size, hipStream_t stream) {
    static int grid = 0;
    if (grid == 0) {
        if (n_in != 19 || out_size != M * DM || ws_size < WS_END) { fprintf(stderr, "kernel_launch: unexpected shapes (n_in %d out %d ws %zu)\n", n_in, out_size, ws_size); grid = -1; return; }
        int dev = 0, cus = 0, per_cu = 0;
        hipGetDevice(&dev); hipDeviceGetAttribute(&cus, hipDeviceAttributeMultiprocessorCount, dev);
        hipFuncSetAttribute((const void*)mega_fwd, hipFuncAttributeMaxDynamicSharedMemorySize, LDS_BYTES);
        hipOccupancyMaxActiveBlocksPerMultiprocessor(&per_cu, (const void*)mega_fwd, 512, LDS_BYTES);
        if (per_cu < 1) { fprintf(stderr, "kernel_launch: occupancy query returned %d\n", per_cu); per_cu = 1; }
        grid = cus * per_cu;
    }
    if (grid < 0) return;
    Args a{};
    a.x = (const float*)d_in[0]; a.pos = (const int*)d_in[1]; a.norm_mix = (const float*)d_in[2]; a.norm_ffn = (const float*)d_in[3]; a.final_norm = (const float*)d_in[4];
    a.w_dkv = (const float*)d_in[5]; a.q_norm = (const float*)d_in[6]; a.kv_norm = (const float*)d_in[7]; a.w_uq = (const float*)d_in[8]; a.w_ukv = (const float*)d_in[9]; a.w_o = (const float*)d_in[10];
    a.w_in = (const float*)d_in[11]; a.ln_g = (const float*)d_in[12]; a.ln_b = (const float*)d_in[13]; a.w_sp = (const float*)d_in[14]; a.b_sp = (const float*)d_in[15]; a.w_out = (const float*)d_in[16];
    a.w_up = (const float*)d_in[17]; a.w_down = (const float*)d_in[18];
    a.out = (float*)d_out; a.ws = (unsigned char*)d_ws;
    void* args[] = {&a};
    hipError_t e = hipLaunchCooperativeKernel((const void*)mega_fwd, dim3(grid), dim3(512), args, LDS_BYTES, stream);
    if (e != hipSuccess) fprintf(stderr, "cooperative launch failed: %s (grid %d)\n", hipGetErrorString(e), grid);
}
```

```cpp
#include <hip/hip_runtime.h>
#include <hip/hip_cooperative_groups.h>
#include <cstdio>
#include <cstdint>
namespace cg = cooperative_groups;

#define LAS __attribute__((address_space(3)))
typedef unsigned short bf16_t;
typedef short bf16x8 __attribute__((ext_vector_type(8)));
typedef float f32x4 __attribute__((ext_vector_type(4)));
typedef float f32x2 __attribute__((ext_vector_type(2)));
typedef float f32x16 __attribute__((ext_vector_type(16)));
typedef unsigned u32x4 __attribute__((ext_vector_type(4)));
typedef unsigned u32x2 __attribute__((ext_vector_type(2)));

constexpr int M = 16384, DM = 1024, SEQ = 4096, NH = 8, FF = 4096, SGW = 2048;
constexpr int LATK = 384;
constexpr float NORM_EPS = 1e-6f, LN_EPS = 1e-5f;
constexpr float QSCALE = 0.07216878364870322f * 1.4426950408889634f;

constexpr size_t MiB = 1u << 20;
constexpr size_t WS_SSQX = 0;
constexpr size_t WS_SSQQ = 1 * MiB;
constexpr size_t WS_SSQKV = 1 * MiB + 256 * 1024;
constexpr size_t WS_LNST = 2 * MiB;
constexpr size_t WS_COS = 4 * MiB, WS_SIN = 6 * MiB;
constexpr size_t WS_KR = 8 * MiB;
constexpr size_t WS_WSP = 10 * MiB;
constexpr size_t WS_CTL = 12 * MiB;
constexpr size_t WS_WA = 16 * MiB;
constexpr size_t WA_LAT = 0, WA_QK = 1 * MiB, WA_V = 3 * MiB, WA_O = 4 * MiB, WA_UP = 6 * MiB, WA_DN = 14 * MiB;
constexpr size_t WS_WB = 40 * MiB;
constexpr size_t WB_INU = 0, WB_INV = 4 * MiB, WB_OUT = 8 * MiB, WB_UP = 12 * MiB, WB_DN = 20 * MiB;
constexpr size_t WS_XB = 72 * MiB;
constexpr size_t WS_HB = 104 * MiB;
constexpr size_t HB_LAT = 0, HB_QN = 16 * MiB, HB_QR = 48 * MiB, HB_KN = 64 * MiB, HB_VT = 96 * MiB;
constexpr size_t HB_U = 0, HB_VTS = 64 * MiB;
constexpr size_t WS_END = 232 * MiB;

constexpr int LDS_BYTES = 147456;

__device__ __forceinline__ unsigned cvt_pk_bf16(float lo, float hi) { unsigned r; asm volatile("v_cvt_pk_bf16_f32 %0, %1, %2" : "=v"(r) : "v"(lo), "v"(hi)); return r; }
__device__ __forceinline__ float bf2f(unsigned short b) { return __builtin_bit_cast(float, (unsigned)b << 16); }
__device__ __forceinline__ u32x4 pack8(f32x4 a, f32x4 b) { u32x4 w; w.x = cvt_pk_bf16(a[0], a[1]); w.y = cvt_pk_bf16(a[2], a[3]); w.z = cvt_pk_bf16(b[0], b[1]); w.w = cvt_pk_bf16(b[2], b[3]); return w; }
__device__ __forceinline__ float sum4(f32x4 v) { return (v[0] + v[1]) + (v[2] + v[3]); }
__device__ __forceinline__ float dot4(f32x4 v) { return (v[0] * v[0] + v[1] * v[1]) + (v[2] * v[2] + v[3] * v[3]); }
__device__ __forceinline__ f32x2 gelu_pk(f32x2 v) {
    f32x2 a; a.x = fminf(__builtin_fabsf(v.x), 7.0f); a.y = fminf(__builtin_fabsf(v.y), 7.0f);
    f32x2 g = a * 2.993315796e-05f + (-7.399407552e-04f);
    g = g * a + 7.977643783e-03f; g = g * a + (-5.323840914e-02f); g = g * a + (-4.589155654e-01f); g = g * a + (-1.151147105e+00f); g = g * a + (-1.0f);
    f32x2 t; t.x = __builtin_amdgcn_exp2f(g.x); t.y = __builtin_amdgcn_exp2f(g.y);
    f32x2 o; o.x = fmaxf(v.x, 0.f) - __builtin_fabsf(v.x) * t.x; o.y = fmaxf(v.y, 0.f) - __builtin_fabsf(v.y) * t.y; return o;
}
__device__ __forceinline__ f32x4 gelu4(f32x4 v) { f32x2 a = gelu_pk((f32x2){v[0], v[1]}), b = gelu_pk((f32x2){v[2], v[3]}); return (f32x4){a.x, a.y, b.x, b.y}; }

namespace pg8 {
constexpr int BM = 256, BK = 64, HALF = 128, HTB = HALF * BK * 2, STAGE_BYTES = 8 * HTB, NXCD = 8, WGM = 4;
__device__ __forceinline__ int lds_byte(int r, int c) { const int st = (r >> 4) * 2 + (c >> 5), rr = r & 15, cc = c & 31, ob = rr * 64 + cc * 2; return st * 1024 + (ob ^ (((ob >> 9) & 1) << 5)); }
__device__ __forceinline__ void stage_rc(int b, int& R, int& C) { const int st = b / 1024, sb = b % 1024, swz = sb ^ (((sb >> 9) & 1) << 5); R = (st >> 1) * 16 + swz / 64; C = (st & 1) * 32 + (swz % 64) / 2; }
__device__ __forceinline__ int perm32(int rho) { const int n = rho >> 4, i = rho & 15; return 8 * (i >> 2) + 4 * n + (i & 3); }

struct Unit { int pm, pn; };
struct Gemm { const bf16_t* A; const bf16_t* Bt; int M, N, K, lda, ldb; int split_pn, kofs2, K2; };

struct StaticOrder {
    int nM, nN, nwg, G, c;
    __device__ void init(int M_, int N_, int G_, int c_) { asm volatile("" : "+s"(G_), "+s"(c_)); nM = M_ / BM; nN = N_ / BM; nwg = nM * nN; G = G_; c = c_; }
    __device__ bool next(int i, Unit& u) const {
        const long L = (long)i * G + c; if (L >= nwg) return false;
        int wgid = (int)L; { const int q = nwg / NXCD, r = nwg % NXCD, xcd = wgid % NXCD, off = wgid / NXCD; wgid = (xcd < r ? xcd * (q + 1) : r * (q + 1) + (xcd - r) * q) + off; }
        const int nig = WGM * nN, gid = wgid / nig, fm = gid * WGM, gsz = (nM - fm) < WGM ? (nM - fm) : WGM;
        u.pm = fm + ((wgid % nig) % gsz); u.pn = (wgid % nig) / gsz; return true;
    }
};

template <class Epi, class Sched>
__device__ __forceinline__ void gemm_phase(LAS unsigned char* lds, const Gemm g, const Sched& S, const Epi& E) {
    int tid_ = threadIdx.x; asm volatile("" : "+v"(tid_));
    const int tid = tid_, wid = __builtin_amdgcn_readfirstlane(tid >> 6), lane = tid & 63, wr = wid >> 2, wc = wid & 3, fr = lane & 15, fq = lane >> 4;
    int nt_ = g.K / BK; asm volatile("" : "+s"(nt_)); const int nt1 = nt_, nt2 = g.K2 / BK;
    unsigned voffA[2], voffB[2];
#pragma unroll
    for (int i = 0; i < 2; ++i) { int R, C; stage_rc(tid * 16 + i * 8192, R, C); const int Rb = (R & ~31) + perm32(R & 31);
        voffA[i] = (unsigned)(R * g.lda + C) * 2u; voffB[i] = (unsigned)(Rb * g.ldb + C) * 2u; }
    const size_t kstep = (size_t)(BK * 2);
    const size_t hA = (size_t)HALF * g.lda * 2, hB = (size_t)HALF * g.ldb * 2, tA = 2 * hA, tB = 2 * hB;
    const unsigned ldsw = (unsigned)wid * 1024u;
    const int aoff = lds_byte(wr * 64 + fr, fq * 8), boff = lds_byte(wc * 32 + fr, fq * 8);
#define PG8_SA(b, h) (((b) * 2 + (h)) * HTB)
#define PG8_SB(b, h) ((4 + (b) * 2 + (h)) * HTB)
#define PG8_STAGE(bufoff, gbase, voff) do { _Pragma("unroll") for (int _i = 0; _i < 2; ++_i) \
        __builtin_amdgcn_global_load_lds((const unsigned*)((const char*)(gbase) + (voff)[_i]), (LAS unsigned*)(lds + (bufoff) + ldsw + _i * 8192), 16, 0, 0); } while (0)
#define PG8_LDA(dst, b, h) do { _Pragma("unroll") for (int m = 0; m < 4; ++m) _Pragma("unroll") for (int k = 0; k < 2; ++k) dst[m][k] = *(const LAS bf16x8*)(lds + PG8_SA(b, h) + aoff + m * 2048 + k * 1024); } while (0)
#define PG8_LDB(dst, b, h) do { _Pragma("unroll") for (int n = 0; n < 2; ++n) _Pragma("unroll") for (int k = 0; k < 2; ++k) dst[n][k] = *(const LAS bf16x8*)(lds + PG8_SB(b, h) + boff + n * 2048 + k * 1024); } while (0)
#define PG8_MMA(ai, bj, At, Bt) do { __builtin_amdgcn_s_setprio(1); _Pragma("unroll") for (int m = 0; m < 4; ++m) _Pragma("unroll") for (int n = 0; n < 2; ++n) _Pragma("unroll") for (int k = 0; k < 2; ++k) \
        acc[ai][bj][m][n] = __builtin_amdgcn_mfma_f32_16x16x32_bf16(Bt[n][k], At[m][k], acc[ai][bj][m][n], 0, 0, 0); __builtin_amdgcn_s_setprio(0); } while (0)
#define PG8_WAIT_V(n) asm volatile("s_waitcnt vmcnt(" #n ")" ::: "memory")
#define PG8_WAIT_L(n) asm volatile("s_waitcnt lgkmcnt(" #n ")" ::: "memory")
#define PG8_BAR __builtin_amdgcn_s_barrier()
#define PG8_SCHED __builtin_amdgcn_sched_barrier(0)
    Unit cur, nxt; int ui = 0;
    if (!S.next(0, cur)) return;
    f32x4 acc[2][2][4][2];
#pragma unroll
    for (int a = 0; a < 2; ++a)
#pragma unroll
        for (int b = 0; b < 2; ++b)
#pragma unroll
            for (int m = 0; m < 4; ++m)
#pragma unroll
                for (int n = 0; n < 2; ++n) acc[a][b][m][n] = (f32x4){0.f, 0.f, 0.f, 0.f};
    bf16x8 At[4][2], B0[2][2], B1[2][2];
    const size_t ko2 = (size_t)g.kofs2 * 2;
    const char* cA = (const char*)g.A + (size_t)cur.pm * tA + (cur.pn >= g.split_pn ? ko2 : 0); const char* cB = (const char*)g.Bt + (size_t)cur.pn * tB + (cur.pn >= g.split_pn ? ko2 : 0);
    PG8_STAGE(PG8_SB(0, 0), cB, voffB); PG8_STAGE(PG8_SB(0, 1), cB + hB, voffB); PG8_STAGE(PG8_SA(0, 0), cA, voffA); PG8_STAGE(PG8_SA(0, 1), cA + hA, voffA);
    if (wr == 1) PG8_BAR;
    PG8_WAIT_V(2); PG8_BAR;
    PG8_STAGE(PG8_SB(1, 0), cB + kstep, voffB); PG8_STAGE(PG8_SA(1, 0), cA + kstep, voffA); PG8_STAGE(PG8_SB(1, 1), cB + hB + kstep, voffB);
    PG8_WAIT_V(6); PG8_BAR;
    for (;;) {
        const bool has_next = S.next(ui + 1, nxt);
        const size_t nko = (has_next && nxt.pn >= g.split_pn) ? ko2 : 0;
        const char* nA = has_next ? (const char*)g.A + (size_t)nxt.pm * tA + nko : cA; const char* nB = has_next ? (const char*)g.Bt + (size_t)nxt.pn * tB + nko : cB;
        const int nt = cur.pn >= g.split_pn ? nt2 : nt1;
#pragma unroll 1
        for (int t = 0; t < nt; t += 2) {
            const bool last = (t == nt - 2);
            const char* a1 = cA + (size_t)(t + 1) * kstep;
            const char* a2 = last ? nA : cA + (size_t)(t + 2) * kstep; const char* b2 = last ? nB : cB + (size_t)(t + 2) * kstep;
            const char* a3 = a2 + kstep; const char* b3 = b2 + kstep;
            PG8_LDB(B0, 0, 0); PG8_LDB(B1, 0, 1); PG8_SCHED; PG8_LDA(At, 0, 0); PG8_STAGE(PG8_SA(1, 1), a1 + hA, voffA);
            PG8_WAIT_V(8); PG8_WAIT_L(0); PG8_BAR; PG8_MMA(0, 0, At, B0); PG8_MMA(0, 1, At, B1); PG8_BAR; PG8_SCHED;
            PG8_LDA(At, 0, 1); PG8_STAGE(PG8_SB(0, 0), b2, voffB); PG8_STAGE(PG8_SB(0, 1), b2 + hB, voffB); PG8_STAGE(PG8_SA(0, 0), a2, voffA);
            PG8_WAIT_V(8); PG8_WAIT_L(0); PG8_BAR; PG8_MMA(1, 0, At, B0); PG8_MMA(1, 1, At, B1); PG8_BAR; PG8_SCHED;
            PG8_LDB(B0, 1, 0); PG8_LDB(B1, 1, 1); PG8_SCHED; PG8_LDA(At, 1, 0); PG8_STAGE(PG8_SA(0, 1), a2 + hA, voffA);
            PG8_WAIT_V(8); PG8_WAIT_L(0); PG8_BAR; PG8_MMA(0, 0, At, B0); PG8_MMA(0, 1, At, B1); PG8_BAR; PG8_SCHED;
            PG8_LDA(At, 1, 1); PG8_STAGE(PG8_SB(1, 0), b3, voffB); PG8_STAGE(PG8_SB(1, 1), b3 + hB, voffB); PG8_STAGE(PG8_SA(1, 0), a3, voffA);
            PG8_WAIT_V(8); PG8_WAIT_L(0); PG8_BAR; PG8_MMA(1, 0, At, B0); PG8_MMA(1, 1, At, B1); PG8_BAR; PG8_SCHED;
        }
        if (wr == 0) PG8_BAR;
        E(acc, cur, wr, wc, fr, fq);
        if (!has_next) break;
#pragma unroll
        for (int a = 0; a < 2; ++a)
#pragma unroll
            for (int b = 0; b < 2; ++b)
#pragma unroll
                for (int m = 0; m < 4; ++m)
#pragma unroll
                    for (int n = 0; n < 2; ++n) acc[a][b][m][n] = (f32x4){0.f, 0.f, 0.f, 0.f};
        cur = nxt; cA = nA; cB = nB; ++ui;
        if (wr == 1) PG8_BAR;
    }
    PG8_WAIT_V(0);
    PG8_BAR;
#undef PG8_SA
#undef PG8_SB
#undef PG8_STAGE
#undef PG8_LDA
#undef PG8_LDB
#undef PG8_MMA
#undef PG8_WAIT_V
#undef PG8_WAIT_L
#undef PG8_BAR
#undef PG8_SCHED
}
}

typedef f32x4 Acc[2][2][4][2];

__device__ __forceinline__ float row_rx(const float* ssq, int row, int fq) {
    float s = sum4(*(const f32x4*)(ssq + (size_t)row * 16 + 4 * fq));
    s += __shfl_xor(s, 16); s += __shfl_xor(s, 32);
    return 1.0f / sqrtf(s * (1.0f / 1024.0f) + NORM_EPS);
}

__device__ __forceinline__ void rows_rx(const float* ssq, int row0, int fq, float (&r)[8]) {
    f32x4 v[8];
#pragma unroll
    for (int i = 0; i < 8; ++i) v[i] = *(const f32x4*)(ssq + (size_t)(row0 + (i >> 2) * 128 + (i & 3) * 16) * 16 + 4 * fq);
#pragma unroll
    for (int i = 0; i < 8; ++i) { float s = sum4(v[i]); s += __shfl_xor(s, 16); s += __shfl_xor(s, 32); r[i] = 1.0f / sqrtf(s * (1.0f / 1024.0f) + NORM_EPS); }
    asm volatile("" ::: "memory");
}
struct EpiUp {
    bf16_t* O; const float* ssq;
    __device__ __forceinline__ void operator()(const Acc& acc, const pg8::Unit& u, int wr, int wc, int fr, int fq) const {
        const int row0 = u.pm * 256 + wr * 64 + fr, col0 = u.pn * 256 + wc * 32 + 8 * fq;
        float rr[8]; rows_rx(ssq, row0, fq, rr);
#pragma unroll
        for (int ai = 0; ai < 2; ++ai)
#pragma unroll
            for (int m = 0; m < 4; ++m) { const int row = row0 + ai * 128 + m * 16; const float r = rr[ai * 4 + m];
#pragma unroll
                for (int bj = 0; bj < 2; ++bj) { f32x4 v0 = acc[ai][bj][m][0] * r, v1 = acc[ai][bj][m][1] * r;
                    v0 = __builtin_elementwise_max(v0, (f32x4){0.f, 0.f, 0.f, 0.f}); v1 = __builtin_elementwise_max(v1, (f32x4){0.f, 0.f, 0.f, 0.f});
                    *(u32x4*)(O + (size_t)row * FF + col0 + bj * 128) = pack8(v0 * v0, v1 * v1); } asm volatile("" ::: "memory"); }
    }
};
struct EpiU {
    bf16_t* O; const float* ssq;
    __device__ __forceinline__ void operator()(const Acc& acc, const pg8::Unit& u, int wr, int wc, int fr, int fq) const {
        const int row0 = u.pm * 256 + wr * 64 + fr, col0 = u.pn * 256 + wc * 32 + 8 * fq;
        float rr[8]; rows_rx(ssq, row0, fq, rr);
#pragma unroll
        for (int ai = 0; ai < 2; ++ai)
#pragma unroll
            for (int m = 0; m < 4; ++m) { const int row = row0 + ai * 128 + m * 16; const float r = rr[ai * 4 + m];
#pragma unroll
                for (int bj = 0; bj < 2; ++bj) { const f32x4 v0 = gelu4(acc[ai][bj][m][0] * r), v1 = gelu4(acc[ai][bj][m][1] * r);
                    *(u32x4*)(O + (size_t)row * SGW + col0 + bj * 128) = pack8(v0, v1); } asm volatile("" ::: "memory"); }
    }
};
struct EpiRes {
    bf16_t* xb; float* ssq;
    __device__ __forceinline__ void operator()(const Acc& acc, const pg8::Unit& u, int wr, int wc, int fr, int fq) const {
        const int row0 = u.pm * 256 + wr * 64 + fr, col0 = u.pn * 256 + wc * 32 + 8 * fq;
#pragma unroll
        for (int ai = 0; ai < 2; ++ai) {
            u32x4 old[4][2];
#pragma unroll
            for (int m = 0; m < 4; ++m)
#pragma unroll
                for (int bj = 0; bj < 2; ++bj) old[m][bj] = *(const u32x4*)(xb + (size_t)(row0 + ai * 128 + m * 16) * DM + col0 + bj * 128);
            asm volatile("" ::: "memory");
#pragma unroll
            for (int m = 0; m < 4; ++m) { const int row = row0 + ai * 128 + m * 16; float s = 0.f;
#pragma unroll
                for (int bj = 0; bj < 2; ++bj) { const size_t p = (size_t)row * DM + col0 + bj * 128;
                    const u32x4 o = old[m][bj];
                    f32x4 x0, x1;
                    x0[0] = __builtin_bit_cast(float, o.x << 16); x0[1] = __builtin_bit_cast(float, o.x & 0xffff0000u); x0[2] = __builtin_bit_cast(float, o.y << 16); x0[3] = __builtin_bit_cast(float, o.y & 0xffff0000u);
                    x1[0] = __builtin_bit_cast(float, o.z << 16); x1[1] = __builtin_bit_cast(float, o.z & 0xffff0000u); x1[2] = __builtin_bit_cast(float, o.w << 16); x1[3] = __builtin_bit_cast(float, o.w & 0xffff0000u);
                    x0 += acc[ai][bj][m][0]; x1 += acc[ai][bj][m][1];
                    *(u32x4*)(xb + p) = pack8(x0, x1); s += dot4(x0) + dot4(x1); }
                s += __shfl_xor(s, 16); s += __shfl_xor(s, 32);
                if (fq == 0) ssq[(size_t)row * 16 + u.pn * 4 + wc] = s; }
            asm volatile("" ::: "memory");
        }
    }
};
struct EpiResFinal {
    const bf16_t* xb; float* out; float* ssq; unsigned* cnt; const float* gain;
    __device__ __forceinline__ void operator()(const Acc& acc_, const pg8::Unit& u, int wr, int wc, int fr, int fq) const {
        Acc& acc = const_cast<Acc&>(acc_);
        const int lane = threadIdx.x & 63;
        const int row0 = u.pm * 256 + wr * 64 + fr, col0 = u.pn * 256 + wc * 32 + 8 * fq;
#pragma unroll
        for (int ai = 0; ai < 2; ++ai) {
            u32x4 old[4][2];
#pragma unroll
            for (int m = 0; m < 4; ++m)
#pragma unroll
                for (int bj = 0; bj < 2; ++bj) old[m][bj] = *(const u32x4*)(xb + (size_t)(row0 + ai * 128 + m * 16) * DM + col0 + bj * 128);
            asm volatile("" ::: "memory");
#pragma unroll
            for (int m = 0; m < 4; ++m) { const int row = row0 + ai * 128 + m * 16; float s = 0.f;
#pragma unroll
                for (int bj = 0; bj < 2; ++bj) { const u32x4 o = old[m][bj];
                    f32x4 x0, x1;
                    x0[0] = __builtin_bit_cast(float, o.x << 16); x0[1] = __builtin_bit_cast(float, o.x & 0xffff0000u); x0[2] = __builtin_bit_cast(float, o.y << 16); x0[3] = __builtin_bit_cast(float, o.y & 0xffff0000u);
                    x1[0] = __builtin_bit_cast(float, o.z << 16); x1[1] = __builtin_bit_cast(float, o.z & 0xffff0000u); x1[2] = __builtin_bit_cast(float, o.w << 16); x1[3] = __builtin_bit_cast(float, o.w & 0xffff0000u);
                    x0 += acc[ai][bj][m][0]; x1 += acc[ai][bj][m][1];
                    acc[ai][bj][m][0] = x0; acc[ai][bj][m][1] = x1; s += dot4(x0) + dot4(x1); }
                s += __shfl_xor(s, 16); s += __shfl_xor(s, 32);
                if (fq == 0) __hip_atomic_store((unsigned*)(ssq + (size_t)row * 16 + u.pn * 4 + wc), __float_as_uint(s), __ATOMIC_RELAXED, __HIP_MEMORY_SCOPE_AGENT); }
            asm volatile("" ::: "memory");
        }
        asm volatile("s_waitcnt vmcnt(0)" ::: "memory");
        unsigned* c = cnt + 64 * u.pm;
        if (lane == 0) __hip_atomic_fetch_add(c, 1u, __ATOMIC_RELAXED, __HIP_MEMORY_SCOPE_AGENT);
        { unsigned sp = 0;
          while ((unsigned)__builtin_amdgcn_readfirstlane(__hip_atomic_load(c, __ATOMIC_RELAXED, __HIP_MEMORY_SCOPE_AGENT)) < 32u) { __builtin_amdgcn_s_sleep(2); if (++sp > (1u << 20)) break; } }
        __builtin_amdgcn_fence(__ATOMIC_ACQUIRE, "agent");
        float rr[8];
        { unsigned long long pv[8][2];
#pragma unroll
          for (int i = 0; i < 8; ++i) { const unsigned long long* p = (const unsigned long long*)(ssq + (size_t)(row0 + (i >> 2) * 128 + (i & 3) * 16) * 16 + 4 * fq);
              pv[i][0] = __hip_atomic_load(p, __ATOMIC_RELAXED, __HIP_MEMORY_SCOPE_AGENT); pv[i][1] = __hip_atomic_load(p + 1, __ATOMIC_RELAXED, __HIP_MEMORY_SCOPE_AGENT); }
#pragma unroll
          for (int i = 0; i < 8; ++i) { float t = (__uint_as_float((unsigned)pv[i][0]) + __uint_as_float((unsigned)(pv[i][0] >> 32))) + (__uint_as_float((unsigned)pv[i][1]) + __uint_as_float((unsigned)(pv[i][1] >> 32)));
              t += __shfl_xor(t, 16); t += __shfl_xor(t, 32); rr[i] = 1.0f / sqrtf(t * (1.0f / 1024.0f) + NORM_EPS); }
          asm volatile("" ::: "memory"); }
        f32x4 gv[2][2];
#pragma unroll
        for (int bj = 0; bj < 2; ++bj) { gv[bj][0] = *(const f32x4*)(gain + col0 + bj * 128); gv[bj][1] = *(const f32x4*)(gain + col0 + bj * 128 + 4); }
#pragma unroll
        for (int ai = 0; ai < 2; ++ai)
#pragma unroll
            for (int m = 0; m < 4; ++m) { const int row = row0 + ai * 128 + m * 16; const float r = rr[ai * 4 + m];
#pragma unroll
                for (int bj = 0; bj < 2; ++bj) { float* op = out + (size_t)row * DM + col0 + bj * 128;
                    *(f32x4*)op = acc[ai][bj][m][0] * r * gv[bj][0]; *(f32x4*)(op + 4) = acc[ai][bj][m][1] * r * gv[bj][1]; }
                asm volatile("" ::: "memory"); }
    }
};
struct EpiLat {
    bf16_t* lat; bf16_t* kr; const float* ssqx; float* ssqq; float* ssqkv; const float* cs; const float* sn;
    __device__ __forceinline__ void operator()(const Acc& acc, const pg8::Unit& u, int wr, int wc, int fr, int fq) const {
        const int row0 = u.pm * 256 + wr * 64 + fr;
        float rr[8]; rows_rx(ssqx, row0, fq, rr);
#pragma unroll
        for (int ai = 0; ai < 2; ++ai)
#pragma unroll
            for (int m = 0; m < 4; ++m) { const int row = row0 + ai * 128 + m * 16; const float r = rr[ai * 4 + m];
                const f32x4 a0 = acc[ai][0][m][0] * r, a1 = acc[ai][0][m][1] * r, b0 = acc[ai][1][m][0] * r, b1 = acc[ai][1][m][1] * r;
                if (u.pn == 0) {
                    bf16_t* o = lat + (size_t)row * LATK + wc * 32 + 8 * fq;
                    *(u32x4*)o = pack8(a0, a1); *(u32x4*)(o + 128) = pack8(b0, b1);
                    float s = dot4(a0) + dot4(a1) + dot4(b0) + dot4(b1); s += __shfl_xor(s, 16); s += __shfl_xor(s, 32);
                    if (fq == 0) ssqq[(size_t)row * 4 + wc] = s;
                } else if (wc < 2) {
                    bf16_t* o = lat + (size_t)row * LATK + 256 + wc * 32 + 8 * fq;
                    *(u32x4*)o = pack8(a0, a1); *(u32x4*)(o + 64) = pack8(b0, b1);
                    float s = dot4(a0) + dot4(a1) + dot4(b0) + dot4(b1); s += __shfl_xor(s, 16); s += __shfl_xor(s, 32);
                    if (fq == 0) { ssqkv[(size_t)row * 4 + wc] = s; ssqkv[(size_t)row * 4 + 2 + wc] = 0.f; }
                } else if (wc == 2) {
                    const float* cp = cs + (size_t)row * 32 + 8 * fq; const float* sp = sn + (size_t)row * 32 + 8 * fq;
                    const f32x4 c0 = *(const f32x4*)cp, c1 = *(const f32x4*)(cp + 4), s0 = *(const f32x4*)sp, s1 = *(const f32x4*)(sp + 4);
                    bf16_t* o = kr + (size_t)row * 64 + 8 * fq;
                    *(u32x4*)o = pack8(a0 * c0 - b0 * s0, a1 * c1 - b1 * s1);
                    *(u32x4*)(o + 32) = pack8(b0 * c0 + a0 * s0, b1 * c1 + a1 * s1);
                }
                asm volatile("" ::: "memory");
            }
    }
};
struct EpiQK {
    bf16_t* qn; bf16_t* qr; bf16_t* kn; const float* ssqq; const float* ssqkv; const float* cs; const float* sn;
    __device__ __forceinline__ void operator()(const Acc& acc, const pg8::Unit& u, int wr, int wc, int fr, int fq) const {
        const int row0 = u.pm * 256 + wr * 64 + fr;
        const bool isq = u.pn < 6;
        float rr[8];
        { const float* sp = isq ? ssqq : ssqkv; f32x4 v[8];
#pragma unroll
          for (int i = 0; i < 8; ++i) v[i] = *(const f32x4*)(sp + (size_t)(row0 + (i >> 2) * 128 + (i & 3) * 16) * 4);
#pragma unroll
          for (int i = 0; i < 8; ++i) rr[i] = (isq ? QSCALE : 1.0f) / sqrtf(sum4(v[i]) * (isq ? (1.0f / 256.0f) : (1.0f / 128.0f)) + NORM_EPS);
          asm volatile("" ::: "memory"); }
#pragma unroll
        for (int ai = 0; ai < 2; ++ai)
#pragma unroll
            for (int m = 0; m < 4; ++m) { const int row = row0 + ai * 128 + m * 16;
                const float r = rr[ai * 4 + m];
                const f32x4 a0 = acc[ai][0][m][0] * r, a1 = acc[ai][0][m][1] * r, b0 = acc[ai][1][m][0] * r, b1 = acc[ai][1][m][1] * r;
                if (u.pn < 4) {
                    bf16_t* o = qn + (size_t)row * 1024 + u.pn * 256 + wc * 32 + 8 * fq;
                    *(u32x4*)o = pack8(a0, a1); *(u32x4*)(o + 128) = pack8(b0, b1);
                } else if (u.pn < 6) {
                    const float* cp = cs + (size_t)row * 32 + 8 * fq; const float* sp = sn + (size_t)row * 32 + 8 * fq;
                    const f32x4 c0 = *(const f32x4*)cp, c1 = *(const f32x4*)(cp + 4), s0 = *(const f32x4*)sp, s1 = *(const f32x4*)(sp + 4);
                    bf16_t* o = qr + (size_t)row * 512 + ((u.pn - 4) * 4 + wc) * 64 + 8 * fq;
                    *(u32x4*)o = pack8(a0 * c0 - b0 * s0, a1 * c1 - b1 * s1);
                    *(u32x4*)(o + 32) = pack8(b0 * c0 + a0 * s0, b1 * c1 + a1 * s1);
                } else {
                    const size_t tb = ((size_t)((row >> 12) * 8 + (u.pn - 6) * 2) * 64 + ((row & 4095) >> 6)) * 8192 + (size_t)(row & 63) * 128 + wc * 32 + 8 * fq;
                    *(u32x4*)(kn + tb) = pack8(a0, a1); *(u32x4*)(kn + tb + (size_t)64 * 8192) = pack8(b0, b1);
                }
                asm volatile("" ::: "memory");
            }
    }
};
struct EpiVT {
    bf16_t* vt; const float* ssqkv;
    __device__ __forceinline__ void operator()(const Acc& acc, const pg8::Unit& u, int wr, int wc, int fr, int fq) const {
        const int lane = threadIdx.x & 63;
        const int tokb = u.pn * 256 + wc * 32 + 8 * fq;
        float rmine; { const int tok = tokb + (fr >> 3) * 128 + (fr & 7); rmine = 1.0f / sqrtf(sum4(*(const f32x4*)(ssqkv + (size_t)tok * 4)) * (1.0f / 128.0f) + NORM_EPS); }
        const int f0 = u.pm * 256 + wr * 64 + fr;
#pragma unroll
        for (int bj = 0; bj < 2; ++bj) {
            f32x4 r0, r1;
#pragma unroll
            for (int e = 0; e < 4; ++e) { r0[e] = __shfl(rmine, (lane & 48) | (bj * 8 + e)); r1[e] = __shfl(rmine, (lane & 48) | (bj * 8 + 4 + e)); }
            const int g16 = u.pn * 256 + bj * 128 + wc * 32 + (fq >> 1) * 16;
            const size_t tbase = ((size_t)((g16 >> 12) * 8) * 64 + ((g16 & 4095) >> 6)) * 8192 + (g16 & 63) + 4 * (fq & 1);
#pragma unroll
            for (int ai = 0; ai < 2; ++ai)
#pragma unroll
                for (int m = 0; m < 4; ++m) { const int f = f0 + ai * 128 + m * 16;
                    const f32x4 v0 = acc[ai][bj][m][0] * r0, v1 = acc[ai][bj][m][1] * r1;
                    bf16_t* o = vt + tbase + (size_t)(f >> 7) * (64 * 8192) + (size_t)(f & 127) * 64;
                    u32x2 w0, w1; w0.x = cvt_pk_bf16(v0[0], v0[1]); w0.y = cvt_pk_bf16(v0[2], v0[3]); w1.x = cvt_pk_bf16(v1[0], v1[1]); w1.y = cvt_pk_bf16(v1[2], v1[3]);
                    *(u32x2*)o = w0; *(u32x2*)(o + 8) = w1; asm volatile("" ::: "memory"); }
        }
    }
};
struct EpiVTS {
    bf16_t* vt; const float* ssqx; float* lnst;
    __device__ __forceinline__ void operator()(const Acc& acc, const pg8::Unit& u, int wr, int wc, int fr, int fq) const {
        const int lane = threadIdx.x & 63;
        const int tokb = u.pn * 256 + wc * 32 + 8 * fq;
        float rmine; { const int tok = tokb + (fr >> 3) * 128 + (fr & 7); const float* p = ssqx + (size_t)tok * 16;
            const float s = (sum4(*(const f32x4*)p) + sum4(*(const f32x4*)(p + 4))) + (sum4(*(const f32x4*)(p + 8)) + sum4(*(const f32x4*)(p + 12)));
            rmine = 1.0f / sqrtf(s * (1.0f / 1024.0f) + NORM_EPS); }
        const int f0 = u.pm * 256 + wr * 64 + fr;
#pragma unroll
        for (int bj = 0; bj < 2; ++bj) {
            f32x4 r0, r1;
#pragma unroll
            for (int e = 0; e < 4; ++e) { r0[e] = __shfl(rmine, (lane & 48) | (bj * 8 + e)); r1[e] = __shfl(rmine, (lane & 48) | (bj * 8 + 4 + e)); }
            f32x4 s10 = {0.f, 0.f, 0.f, 0.f}, s11 = s10, s20 = s10, s21 = s10;
            const int tok0 = tokb + bj * 128;
#pragma unroll
            for (int ai = 0; ai < 2; ++ai)
#pragma unroll
                for (int m = 0; m < 4; ++m) { const int f = f0 + ai * 128 + m * 16;
                    const f32x4 v0 = gelu4(acc[ai][bj][m][0] * r0), v1 = gelu4(acc[ai][bj][m][1] * r1);
                    *(u32x4*)(vt + (size_t)f * M + tok0) = pack8(v0, v1);
                    s10 += v0; s11 += v1; s20 += v0 * v0; s21 += v1 * v1; asm volatile("" ::: "memory"); }
#pragma unroll
            for (int o = 1; o < 16; o <<= 1) {
#pragma unroll
                for (int e = 0; e < 4; ++e) { s10[e] += __shfl_xor(s10[e], o); s11[e] += __shfl_xor(s11[e], o); s20[e] += __shfl_xor(s20[e], o); s21[e] += __shfl_xor(s21[e], o); } }
            if (fr == 0) {
                const int slot = u.pm * 2 + wr;
#pragma unroll
                for (int e = 0; e < 4; ++e) {
                    *(f32x2*)(lnst + ((size_t)(tok0 + e) * 16 + slot) * 2) = (f32x2){s10[e], s20[e]};
                    *(f32x2*)(lnst + ((size_t)(tok0 + 4 + e) * 16 + slot) * 2) = (f32x2){s11[e], s21[e]}; }
            }
        }
    }
};

namespace att {
constexpr int KROW = 200, VROW = 72, KBYTES = 64 * KROW * 2, VBYTES = 128 * VROW * 2, BUFB = KBYTES + VBYTES;
__device__ __forceinline__ int crow(int r, int hi) { return (r & 3) + 8 * (r >> 2) + 4 * hi; }
__device__ __forceinline__ float max2f(float a, float b) { float r; asm volatile("v_max_f32_e32 %0, %1, %2" : "=v"(r) : "v"(a), "v"(b)); return r; }
__device__ __forceinline__ float add2f(float a, float b) { float r; asm volatile("v_add_f32_e32 %0, %1, %2" : "=v"(r) : "v"(a), "v"(b)); return r; }
__device__ __forceinline__ float max3f(float a, float b, float c) { float r; asm("v_max3_f32 %0, %1, %2, %3" : "=v"(r) : "v"(a), "v"(b), "v"(c)); return r; }

__device__ __forceinline__ void attn_unit(LAS unsigned char* lds, int b, int h, int qb, const bf16_t* Qn, const bf16_t* Qr, const bf16_t* __restrict__ Kn,
                                          const bf16_t* __restrict__ Kr, const bf16_t* __restrict__ Vt, bf16_t* O) {
    int tid_ = threadIdx.x; asm volatile("" : "+v"(tid_));
    const int tid = tid_, lane = tid & 63, r32 = lane & 31, hi = lane >> 5, wid = __builtin_amdgcn_readfirstlane(tid >> 6);
    const int tok0 = b * SEQ, q0 = qb * 256;
    const int qtok = tok0 + q0 + wid * 32 + r32;
    bf16x8 qf[12];
#pragma unroll
    for (int ks = 0; ks < 8; ++ks) qf[ks] = *(const bf16x8*)(Qn + (size_t)qtok * 1024 + h * 128 + ks * 16 + hi * 8);
#pragma unroll
    for (int ks = 0; ks < 4; ++ks) qf[8 + ks] = *(const bf16x8*)(Qr + (size_t)qtok * 512 + h * 64 + ks * 16 + hi * 8);
    f32x16 o[4];
#pragma unroll
    for (int d = 0; d < 4; ++d)
#pragma unroll
        for (int r = 0; r < 16; ++r) o[d][r] = 0.f;
    float mrow = -INFINITY, lrow = 0.f;
    const int NT = 4 * (qb + 1);
    u32x4 st[5];
    const int krow0 = tid >> 4, kcc = tid & 15, rrow = tid >> 3, rcc = tid & 7;
    const bf16_t* kn_src = Kn + (size_t)(b * 8 + h) * (64 * 8192) + krow0 * 128 + kcc * 8;
    const bf16_t* kr_src = Kr + (size_t)(tok0 + rrow) * 64 + rcc * 8;
    const bf16_t* vt_src = Vt + (size_t)(b * 8 + h) * (64 * 8192) + rrow * 64 + rcc * 8;
#define ATT_LOAD(j) do { const size_t tb_ = (size_t)(j) * 64; \
        st[0] = *(const u32x4*)(kn_src + tb_ * 128); st[1] = *(const u32x4*)(kn_src + tb_ * 128 + 4096); \
        st[2] = *(const u32x4*)(kr_src + tb_ * 64); \
        st[3] = *(const u32x4*)(vt_src + tb_ * 128); st[4] = *(const u32x4*)(vt_src + tb_ * 128 + 4096); } while (0)
#define ATT_STORE(buf) do { LAS unsigned char* ks_ = lds + (buf) * BUFB; LAS unsigned char* vs_ = ks_ + KBYTES; \
        *(LAS u32x4*)(ks_ + (krow0 * KROW + kcc * 8) * 2) = st[0]; *(LAS u32x4*)(ks_ + ((krow0 + 32) * KROW + kcc * 8) * 2) = st[1]; \
        *(LAS u32x4*)(ks_ + (rrow * KROW + 128 + rcc * 8) * 2) = st[2]; \
        *(LAS u32x4*)(vs_ + (rrow * VROW + rcc * 8) * 2) = st[3]; *(LAS u32x4*)(vs_ + ((rrow + 64) * VROW + rcc * 8) * 2) = st[4]; } while (0)
    ATT_LOAD(0);
    for (int j = 0; j < NT; ++j) {
        const int buf = j & 1;
        ATT_STORE(buf);
        __syncthreads();
        if (j + 1 < NT) ATT_LOAD(j + 1);
        const unsigned ka = (unsigned)(uintptr_t)(lds + buf * BUFB) + (unsigned)((r32 * KROW + hi * 8) * 2);
        const unsigned va = (unsigned)(uintptr_t)(lds + buf * BUFB) + (unsigned)(KBYTES + (r32 * VROW + hi * 8) * 2);
#define DSR(dst, addr, off) asm volatile("ds_read_b128 %0, %1 offset:%2" : "=v"(dst) : "v"(addr), "n"(off) : "memory")
#define LWAIT(n, f) asm volatile("s_waitcnt lgkmcnt(" #n ")" : "+v"(f[0]), "+v"(f[1]), "+v"(f[2]), "+v"(f[3]) :: "memory")
#define KREAD(f, g) do { DSR(f[0], ka, (2 * (g)) * 32); DSR(f[1], ka, 12800 + (2 * (g)) * 32); DSR(f[2], ka, (2 * (g) + 1) * 32); DSR(f[3], ka, 12800 + (2 * (g) + 1) * 32); } while (0)
#define KMMA(f, g) do { p0 = __builtin_amdgcn_mfma_f32_32x32x16_bf16(f[0], qf[2 * (g)], p0, 0, 0, 0); p1 = __builtin_amdgcn_mfma_f32_32x32x16_bf16(f[1], qf[2 * (g)], p1, 0, 0, 0); \
                         p0 = __builtin_amdgcn_mfma_f32_32x32x16_bf16(f[2], qf[2 * (g) + 1], p0, 0, 0, 0); p1 = __builtin_amdgcn_mfma_f32_32x32x16_bf16(f[3], qf[2 * (g) + 1], p1, 0, 0, 0); } while (0)
#define VREAD(f, ks) do { DSR(f[0], va, (ks) * 32); DSR(f[1], va, 4608 + (ks) * 32); DSR(f[2], va, 9216 + (ks) * 32); DSR(f[3], va, 13824 + (ks) * 32); } while (0)
#define VMMA(f, ks) do { o[0] = __builtin_amdgcn_mfma_f32_32x32x16_bf16(f[0], pk[ks], o[0], 0, 0, 0); o[1] = __builtin_amdgcn_mfma_f32_32x32x16_bf16(f[1], pk[ks], o[1], 0, 0, 0); \
                          o[2] = __builtin_amdgcn_mfma_f32_32x32x16_bf16(f[2], pk[ks], o[2], 0, 0, 0); o[3] = __builtin_amdgcn_mfma_f32_32x32x16_bf16(f[3], pk[ks], o[3], 0, 0, 0); } while (0)
        static_assert(32 * KROW * 2 == 12800 && 32 * VROW * 2 == 4608, "fragment offsets");
        if (!(j >= NT - 4 && 64 * (j - (NT - 4)) > wid * 32 + 31)) {
        f32x16 p0, p1;
#pragma unroll
        for (int r = 0; r < 16; ++r) { p0[r] = 0.f; p1[r] = 0.f; }
        bf16x8 fa[4], fb[4];
        KREAD(fa, 0); KREAD(fb, 1);
        LWAIT(4, fa); KMMA(fa, 0); KREAD(fa, 2);
        LWAIT(4, fb); KMMA(fb, 1); KREAD(fb, 3);
        LWAIT(4, fa); KMMA(fa, 2); KREAD(fa, 4);
        LWAIT(4, fb); KMMA(fb, 3); KREAD(fb, 5);
        LWAIT(4, fa); KMMA(fa, 4); VREAD(fa, 0);
        LWAIT(4, fb); KMMA(fb, 5); VREAD(fb, 1);
        asm volatile("s_nop 15\n\ts_nop 7" : "+v"(p0), "+v"(p1));
        const int jb = j - (NT - 4);
        if (jb >= 0 && 64 * jb + 63 > wid * 32) {
            const int qrel = wid * 32 + r32, kb = 64 * jb + 4 * hi;
#pragma unroll
            for (int r = 0; r < 16; ++r) { const int kv = kb + (r & 3) + 8 * (r >> 2); if (kv > qrel) p0[r] = -INFINITY; if (kv + 32 > qrel) p1[r] = -INFINITY; }
        }
        float mxa = max3f(p0[0], p0[1], p1[0]), mxb = max3f(p0[2], p0[3], p1[1]); mxa = max3f(mxa, p1[2], p1[3]);
#pragma unroll
        for (int r = 4; r < 16; r += 4) { mxa = max3f(mxa, p0[r], p0[r + 1]); mxb = max3f(mxb, p0[r + 2], p0[r + 3]); mxa = max3f(mxa, p1[r], p1[r + 1]); mxb = max3f(mxb, p1[r + 2], p1[r + 3]); }
        float mx = fmaxf(mxa, mxb);
        { const unsigned ma = __float_as_uint(mx); const auto rr = __builtin_amdgcn_permlane32_swap(ma, ma, false, false);
          const unsigned r0 = rr[0], r1 = rr[1];
          mx = max2f(__uint_as_float(r0), __uint_as_float(r1)); }
        const float mnew = fmaxf(mrow, mx);
        const float alpha = __builtin_amdgcn_exp2f(mrow - mnew);
        mrow = mnew;
        float ls = 0.f;
#pragma unroll
        for (int r = 0; r < 16; ++r) { p0[r] = __builtin_amdgcn_exp2f(p0[r] - mnew); p1[r] = __builtin_amdgcn_exp2f(p1[r] - mnew); ls += p0[r] + p1[r]; }
        lrow = lrow * alpha + ls;
#pragma unroll
        for (int d = 0; d < 4; ++d)
#pragma unroll
            for (int r = 0; r < 16; ++r) o[d][r] *= alpha;
        bf16x8 pk[4];
        { u32x4 w;
          w.x = cvt_pk_bf16(p0[0], p0[1]); w.y = cvt_pk_bf16(p0[2], p0[3]); w.z = cvt_pk_bf16(p0[4], p0[5]); w.w = cvt_pk_bf16(p0[6], p0[7]); pk[0] = __builtin_bit_cast(bf16x8, w);
          w.x = cvt_pk_bf16(p0[8], p0[9]); w.y = cvt_pk_bf16(p0[10], p0[11]); w.z = cvt_pk_bf16(p0[12], p0[13]); w.w = cvt_pk_bf16(p0[14], p0[15]); pk[1] = __builtin_bit_cast(bf16x8, w);
          w.x = cvt_pk_bf16(p1[0], p1[1]); w.y = cvt_pk_bf16(p1[2], p1[3]); w.z = cvt_pk_bf16(p1[4], p1[5]); w.w = cvt_pk_bf16(p1[6], p1[7]); pk[2] = __builtin_bit_cast(bf16x8, w);
          w.x = cvt_pk_bf16(p1[8], p1[9]); w.y = cvt_pk_bf16(p1[10], p1[11]); w.z = cvt_pk_bf16(p1[12], p1[13]); w.w = cvt_pk_bf16(p1[14], p1[15]); pk[3] = __builtin_bit_cast(bf16x8, w); }
        LWAIT(4, fa); VMMA(fa, 0); VREAD(fa, 2);
        LWAIT(4, fb); VMMA(fb, 1); VREAD(fb, 3);
        LWAIT(4, fa); VMMA(fa, 2);
        LWAIT(0, fb); VMMA(fb, 3);
        }
#undef DSR
#undef LWAIT
#undef KREAD
#undef KMMA
#undef VREAD
#undef VMMA
    }
#undef ATT_LOAD
#undef ATT_STORE
    float ltot; { const unsigned la = __float_as_uint(lrow); const auto rr = __builtin_amdgcn_permlane32_swap(la, la, false, false);
                  const unsigned r0 = rr[0], r1 = rr[1];
                  ltot = add2f(__uint_as_float(r0), __uint_as_float(r1)); }
    const float inv = 1.0f / ltot;
    bf16_t* op = O + (size_t)qtok * 1024 + h * 128 + 4 * hi;
#pragma unroll
    for (int d = 0; d < 4; ++d)
#pragma unroll
        for (int rg = 0; rg < 4; ++rg) { u32x2 w; w.x = cvt_pk_bf16(o[d][4 * rg] * inv, o[d][4 * rg + 1] * inv); w.y = cvt_pk_bf16(o[d][4 * rg + 2] * inv, o[d][4 * rg + 3] * inv);
            *(u32x2*)(op + 32 * d + 8 * rg) = w; }
}
}

namespace sgu {
constexpr int AROW = 136;
constexpr int A_BYTES = 256 * AROW * 2, B_BYTES = 128 * AROW * 2, ST_OFF = A_BYTES + B_BYTES, MROW = 264;
static_assert(128 * MROW * 2 <= A_BYTES, "the mixed tile is staged in the A tile's space");
__device__ __forceinline__ void phase(LAS unsigned char* lds, int G, int bx, const bf16_t* __restrict__ vT, const float* __restrict__ lnst, const float* __restrict__ lng,
                                      const float* __restrict__ lnb, const bf16_t* __restrict__ wsp, const float* __restrict__ bsp, bf16_t* U) {
    int tid_ = threadIdx.x; asm volatile("" : "+v"(tid_));
    const int tid = tid_, lane = tid & 63, r32 = lane & 31, hi = lane >> 5, wid = __builtin_amdgcn_readfirstlane(tid >> 6);
    LAS float* mus = (LAS float*)(lds + ST_OFF);
    LAS float* rss = mus + 256;
    if (bx >= 1024) return;
    u32x4 rawv[8]; f32x4 stv[8];
    const int vd = tid >> 4, vcc = tid & 15;
#define SGU_LOADV(it) do { const int c_ = (it) >> 3, g_ = (it) & 7; const bf16_t* p_ = vT + (size_t)(g_ * 256 + vd) * M + c_ * 128 + vcc * 8; \
        _Pragma("unroll") for (int i = 0; i < 8; ++i) rawv[i] = *(const u32x4*)(p_ + (size_t)(32 * i) * M); } while (0)
#define SGU_LOADST(it) do { if (tid < 128) { const float* p_ = lnst + (size_t)(((it) >> 3) * 128 + tid) * 32; \
        _Pragma("unroll") for (int i = 0; i < 8; ++i) stv[i] = *(const f32x4*)(p_ + 4 * i); } } while (0)
#define SGU_PUTST(slot) do { if (tid < 128) { float s1 = 0.f, s2 = 0.f; \
        _Pragma("unroll") for (int i = 0; i < 8; ++i) { s1 += stv[i][0] + stv[i][2]; s2 += stv[i][1] + stv[i][3]; } \
        const float mean = s1 * (1.0f / 2048.0f), var = fmaxf(s2 * (1.0f / 2048.0f) - mean * mean, 0.f); \
        mus[(slot) * 128 + tid] = mean; rss[(slot) * 128 + tid] = 1.0f / sqrtf(var + LN_EPS); } } while (0)
    SGU_LOADST(bx); SGU_LOADV(bx);
    SGU_PUTST(0);
    int gload = -1, k = 0;
    for (int it = bx; it < 1024; it += G, ++k) {
        const int c = it >> 3, g = it & 7, tokbase = c * 128, slot = k & 1;
        const bool has_next = it + G < 1024;
        if (g != gload) {
            if (gload >= 0) __syncthreads();
#pragma unroll
            for (int i = 0; i < 4; ++i) { const int ch = tid + 512 * i, t = ch >> 4, cc = ch & 15;
                *(LAS u32x4*)(lds + A_BYTES + (t * AROW + cc * 8) * 2) = *(const u32x4*)(wsp + ((size_t)g * 128 + t) * 128 + cc * 8); }
            gload = g;
        }
        __syncthreads();
#pragma unroll
        for (int i = 0; i < 8; ++i) { const int d = vd + 32 * i;
            const float gg = lng[g * 256 + d], bb = lnb[g * 256 + d];
            float v[8];
#pragma unroll
            for (int e = 0; e < 4; ++e) { const unsigned w = rawv[i][e]; v[2 * e] = __builtin_bit_cast(float, w << 16); v[2 * e + 1] = __builtin_bit_cast(float, w & 0xffff0000u); }
#pragma unroll
            for (int e = 0; e < 8; ++e) { const int sidx = slot * 128 + vcc * 8 + e; v[e] = (v[e] - mus[sidx]) * rss[sidx] * gg + bb; }
            u32x4 w; w.x = cvt_pk_bf16(v[0], v[1]); w.y = cvt_pk_bf16(v[2], v[3]); w.z = cvt_pk_bf16(v[4], v[5]); w.w = cvt_pk_bf16(v[6], v[7]);
            *(LAS u32x4*)(lds + (d * AROW + vcc * 8) * 2) = w; }
        __syncthreads();
        if (has_next) { SGU_LOADST(it + G); SGU_LOADV(it + G); }
        u32x4 uu[8];
        { const bf16_t* up = U + (size_t)(tokbase + (tid >> 5)) * SGW + g * 256 + (tid & 31) * 8;
#pragma unroll
          for (int i = 0; i < 8; ++i) uu[i] = *(const u32x4*)(up + (size_t)(16 * i) * SGW); }
        f32x16 acc[4];
#pragma unroll
        for (int tb = 0; tb < 4; ++tb)
#pragma unroll
            for (int r = 0; r < 16; ++r) acc[tb][r] = 0.f;
        const LAS unsigned char* ap = lds + ((wid * 32 + r32) * AROW + hi * 8) * 2;
        const LAS unsigned char* bp = lds + A_BYTES + (r32 * AROW + hi * 8) * 2;
#pragma unroll
        for (int ks = 0; ks < 8; ++ks) {
            const bf16x8 a = *(const LAS bf16x8*)(ap + ks * 32);
#pragma unroll
            for (int tb = 0; tb < 4; ++tb) if (16 * ks <= 32 * tb + 31) {
                const bf16x8 bq = *(const LAS bf16x8*)(bp + tb * 32 * AROW * 2 + ks * 32);
                acc[tb] = __builtin_amdgcn_mfma_f32_32x32x16_bf16(a, bq, acc[tb], 0, 0, 0);
            }
        }
        __syncthreads();
#pragma unroll
        for (int tb = 0; tb < 4; ++tb) { const int t = tb * 32 + r32; const float bias = bsp[g * 128 + t];
#pragma unroll
            for (int rg = 0; rg < 4; ++rg) { u32x2 w; w.x = cvt_pk_bf16(acc[tb][4 * rg] + bias, acc[tb][4 * rg + 1] + bias); w.y = cvt_pk_bf16(acc[tb][4 * rg + 2] + bias, acc[tb][4 * rg + 3] + bias);
                *(LAS u32x2*)(lds + (t * MROW + wid * 32 + 8 * rg + 4 * hi) * 2) = w; } }
        __syncthreads();
        { bf16_t* up = U + (size_t)(tokbase + (tid >> 5)) * SGW + g * 256 + (tid & 31) * 8;
#pragma unroll
          for (int i = 0; i < 8; ++i) { const u32x4 mm = *(const LAS u32x4*)(lds + (((tid >> 5) + 16 * i) * MROW + (tid & 31) * 8) * 2); const u32x4 u4 = uu[i];
              u32x4 w;
#pragma unroll
              for (int e = 0; e < 4; ++e) w[e] = cvt_pk_bf16(__builtin_bit_cast(float, u4[e] << 16) * __builtin_bit_cast(float, mm[e] << 16), __builtin_bit_cast(float, u4[e] & 0xffff0000u) * __builtin_bit_cast(float, mm[e] & 0xffff0000u));
              *(u32x4*)(up + (size_t)(16 * i) * SGW) = w; } }
        if (has_next) SGU_PUTST(slot ^ 1);
    }
    __syncthreads();
#undef SGU_LOADV
#undef SGU_LOADST
#undef SGU_PUTST
}
}

__device__ __forceinline__ float wave_sum(float v) {
#pragma unroll
    for (int o = 1; o < 64; o <<= 1) v += __shfl_xor(v, o);
    return v;
}
struct Src { const float* p; int ld; const float* g; };
template <class F>
__device__ __forceinline__ void conv_matrix(const F& f, bf16_t* WT, int Kd, int Nd, LAS float* scr, int gw, int NGW, int lane_) {
    (void)lane_; int lt_ = threadIdx.x; asm volatile("" : "+v"(lt_)); const int lane = lt_ & 63;
    const int nblk = Nd / 32, nitems = (Kd / 64) * nblk;
    const int lr = lane >> 3, lc = (lane & 7) * 4;
    for (int it = gw; it < nitems; it += NGW) {
        const int kb = it / nblk, nb = it % nblk, k0 = 64 * kb, n0 = 32 * nb;
        const Src sc = f(k0, n0);
        if (sc.p) {
            f32x4 v[8]; float gg[8];
#pragma unroll
            for (int i = 0; i < 8; ++i) { const int kk = 8 * i + lr; v[i] = *(const f32x4*)(sc.p + (size_t)kk * sc.ld + lc); gg[i] = sc.g ? sc.g[kk] : 1.0f; }
#pragma unroll
            for (int i = 0; i < 8; ++i) { const int kk = 8 * i + lr; LAS float* d = scr + kk * 33 + lc; d[0] = v[i][0] * gg[i]; d[1] = v[i][1] * gg[i]; d[2] = v[i][2] * gg[i]; d[3] = v[i][3] * gg[i]; }
        } else {
#pragma unroll
            for (int i = 0; i < 8; ++i) { const int kk = 8 * i + lr; LAS float* d = scr + kk * 33 + lc; d[0] = 0.f; d[1] = 0.f; d[2] = 0.f; d[3] = 0.f; }
        }
        asm volatile("s_waitcnt lgkmcnt(0)" ::: "memory");
        const int c = lane & 7;
#pragma unroll
        for (int j = 0; j < 4; ++j) { const int n = (lane >> 3) + 8 * j; const LAS float* s = scr + (8 * c) * 33 + n;
            u32x4 o; o.x = cvt_pk_bf16(s[0 * 33], s[1 * 33]); o.y = cvt_pk_bf16(s[2 * 33], s[3 * 33]); o.z = cvt_pk_bf16(s[4 * 33], s[5 * 33]); o.w = cvt_pk_bf16(s[6 * 33], s[7 * 33]);
            *(u32x4*)(WT + (size_t)(n0 + n) * Kd + k0 + 8 * c) = o; }
        asm volatile("s_waitcnt lgkmcnt(0)" ::: "memory");
    }
}

struct Args {
    const float* x; const int* pos; const float* norm_mix; const float* norm_ffn; const float* final_norm;
    const float* w_dkv; const float* q_norm; const float* kv_norm; const float* w_uq; const float* w_ukv; const float* w_o;
    const float* w_in; const float* ln_g; const float* ln_b; const float* w_sp; const float* b_sp; const float* w_out;
    const float* w_up; const float* w_down;
    float* out; unsigned char* ws;
};

__device__ __forceinline__ void conv_set_a(const Args& a, int j, LAS float* scr, int gw, int NGW, int lane) {
    const int L = 2 * j;
    unsigned char* wa = a.ws + WS_WA;
    { const float* W = a.w_dkv + (size_t)j * 1024 * 448; const float* g = a.norm_mix + L * 1024;
      auto f = [=](int k0, int n0) -> Src { int c;
          if (n0 < 256) c = n0; else { const int l = n0 - 256, h2 = l >> 7, ll = l & 127; c = ll < 64 ? 256 + h2 * 64 + ll : (ll < 96 ? 384 + h2 * 32 + (ll - 64) : -1); }
          return c < 0 ? Src{nullptr, 0, nullptr} : Src{W + (size_t)k0 * 448 + c, 448, g + k0}; };
      conv_matrix(f, (bf16_t*)(wa + WA_LAT), 1024, 512, scr, gw, NGW, lane); }
    { const float* Wq = a.w_uq + (size_t)j * 256 * 1536; const float* Wkv = a.w_ukv + (size_t)j * 128 * 2048; const float* gq = a.q_norm + j * 256; const float* gk = a.kv_norm + j * 128;
      auto f = [=](int k0, int n0) -> Src {
          if (n0 < 1536) { if (k0 >= 256) return Src{nullptr, 0, nullptr}; int c;
              if (n0 < 1024) c = (n0 >> 7) * 192 + (n0 & 127); else { const int l = n0 - 1024, uu = l >> 8, ll = l & 255, half = ll >> 7, hh = (ll & 127) >> 5; c = (uu * 4 + hh) * 192 + 128 + half * 32; }
              return Src{Wq + (size_t)k0 * 1536 + c, 1536, gq + k0}; }
          if (k0 < 256) return Src{nullptr, 0, nullptr}; const int l = n0 - 1536;
          return Src{Wkv + (size_t)(k0 - 256) * 2048 + (l >> 7) * 256 + (l & 127), 2048, gk + (k0 - 256)}; };
      conv_matrix(f, (bf16_t*)(wa + WA_QK), LATK, 2560, scr, gw, NGW, lane); }
    { const float* Wkv = a.w_ukv + (size_t)j * 128 * 2048; const float* gk = a.kv_norm + j * 128;
      auto f = [=](int k0, int n0) -> Src { if (k0 < 256) return Src{nullptr, 0, nullptr};
          return Src{Wkv + (size_t)(k0 - 256) * 2048 + (n0 >> 7) * 256 + 128 + (n0 & 127), 2048, gk + (k0 - 256)}; };
      conv_matrix(f, (bf16_t*)(wa + WA_V), LATK, 1024, scr, gw, NGW, lane); }
    { const float* W = a.w_o + (size_t)j * 1024 * 1024;
      auto f = [=](int k0, int n0) -> Src { return Src{W + (size_t)k0 * 1024 + n0, 1024, nullptr}; };
      conv_matrix(f, (bf16_t*)(wa + WA_O), 1024, 1024, scr, gw, NGW, lane); }
    { const float* W = a.w_up + (size_t)L * 1024 * 4096; const float* g = a.norm_ffn + L * 1024;
      auto f = [=](int k0, int n0) -> Src { return Src{W + (size_t)k0 * 4096 + n0, 4096, g + k0}; };
      conv_matrix(f, (bf16_t*)(wa + WA_UP), 1024, 4096, scr, gw, NGW, lane); }
    { const float* W = a.w_down + (size_t)L * 4096 * 1024;
      auto f = [=](int k0, int n0) -> Src { return Src{W + (size_t)k0 * 1024 + n0, 1024, nullptr}; };
      conv_matrix(f, (bf16_t*)(wa + WA_DN), 4096, 1024, scr, gw, NGW, lane); }
}
__device__ __forceinline__ void conv_set_b(const Args& a, int j, LAS float* scr, int gw, int NGW, int lane) {
    const int L = 2 * j + 1;
    unsigned char* wb = a.ws + WS_WB;
    { const float* W = a.w_in + (size_t)j * 1024 * 4096; const float* g = a.norm_mix + L * 1024;
      auto f = [=](int k0, int n0) -> Src { return Src{W + (size_t)k0 * 4096 + n0, 4096, g + k0}; };
      conv_matrix(f, (bf16_t*)(wb + WB_INU), 1024, 2048, scr, gw, NGW, lane);
      auto f2 = [=](int k0, int n0) -> Src { return Src{W + (size_t)k0 * 4096 + 2048 + n0, 4096, g + k0}; };
      conv_matrix(f2, (bf16_t*)(wb + WB_INV), 1024, 2048, scr, gw, NGW, lane); }
    { const float* W = a.w_out + (size_t)j * 2048 * 1024;
      auto f = [=](int k0, int n0) -> Src { return Src{W + (size_t)k0 * 1024 + n0, 1024, nullptr}; };
      conv_matrix(f, (bf16_t*)(wb + WB_OUT), 2048, 1024, scr, gw, NGW, lane); }
    { const float* W = a.w_up + (size_t)L * 1024 * 4096; const float* g = a.norm_ffn + L * 1024;
      auto f = [=](int k0, int n0) -> Src { return Src{W + (size_t)k0 * 4096 + n0, 4096, g + k0}; };
      conv_matrix(f, (bf16_t*)(wb + WB_UP), 1024, 4096, scr, gw, NGW, lane); }
    { const float* W = a.w_down + (size_t)L * 4096 * 1024;
      auto f = [=](int k0, int n0) -> Src { return Src{W + (size_t)k0 * 1024 + n0, 1024, nullptr}; };
      conv_matrix(f, (bf16_t*)(wb + WB_DN), 4096, 1024, scr, gw, NGW, lane); }
}

#define XB_TMO      128
#define XB_XCNT(j)  (256  + 64 * (j))
#define XB_XSUB(j)  (1280 + 64 * (j))
#define XB_XGEN(j)  (2304 + 64 * (j))
#define XB_TOP      3328
#define XB_TOPGEN   3392
#define XCD_BAR_WORDS 3456
#define XB_SPIN_CAP (1u << 22)
__device__ __forceinline__ unsigned xb_ld(unsigned* p)              { return __hip_atomic_load(p, __ATOMIC_RELAXED, __HIP_MEMORY_SCOPE_AGENT); }
__device__ __forceinline__ unsigned xb_add(unsigned* p, unsigned v) { return __hip_atomic_fetch_add(p, v, __ATOMIC_RELAXED, __HIP_MEMORY_SCOPE_AGENT); }
__device__ __forceinline__ unsigned xb_xcc_id() { return (unsigned)__builtin_amdgcn_s_getreg((3 << 11) | 20) & 0xFu; }
#define XB_SPIN(cond, bar) do { unsigned _sp = 0; while (cond) { __builtin_amdgcn_s_sleep(1); \
    if ((++_sp & 255u) == 0u) { if (xb_ld(&(bar)[XB_TMO])) break; if (_sp > XB_SPIN_CAP) { atomicAdd(&(bar)[XB_TMO], 1u); break; } } } } while (0)
struct XcdBarrier { unsigned* bar; unsigned x; volatile LAS unsigned* st; };
__device__ __forceinline__ XcdBarrier xcd_barrier_post(unsigned* bar, volatile LAS unsigned* st) {
    XcdBarrier b; b.bar = bar; b.x = xb_xcc_id(); b.st = st;
    if (threadIdx.x == 0) (void)xb_add(&bar[XB_XCNT(b.x)], 1u);
    return b;
}
__device__ __forceinline__ void xcd_barrier_complete(unsigned* bar, unsigned x, unsigned& nloc, unsigned& nx) {
    const unsigned G = gridDim.x * gridDim.y * gridDim.z;
    unsigned sum, cnt, mine, sp = 0u;
    for (;;) {
        sum = 0u; cnt = 0u; mine = 0u;
#pragma unroll
        for (unsigned j = 0; j < 16; ++j) { const unsigned c = xb_ld(&bar[XB_XCNT(j)]); sum += c; cnt += (c > 0u) ? 1u : 0u; mine = (j == x) ? c : mine; }
        if (sum == G) break;
        __builtin_amdgcn_s_sleep(1);
        if ((++sp & 255u) == 0u) { if (xb_ld(&bar[XB_TMO])) break; if (sp > XB_SPIN_CAP) { atomicAdd(&bar[XB_TMO], 1u); break; } }
    }
    nloc = mine > 0u ? mine : 1u; nx = cnt > 0u ? cnt : 1u;
}
__device__ __forceinline__ void xcd_barrier(const XcdBarrier& b) {
    asm volatile("s_waitcnt vmcnt(0)" ::: "memory");
    __syncthreads();
    if (threadIdx.x == 0) {
        unsigned* bar = b.bar;
        __builtin_amdgcn_s_waitcnt(0);
        unsigned nloc = b.st[0], nx = b.st[1];
        if (nloc == 0u) { xcd_barrier_complete(bar, b.x, nloc, nx); b.st[0] = nloc; b.st[1] = nx; }
        const unsigned old = xb_add(&bar[XB_XSUB(b.x)], 1u);
        const unsigned gen = old / nloc;
        if (old + 1u == (gen + 1u) * nloc) {
            __builtin_amdgcn_fence(__ATOMIC_RELEASE, "agent");
            asm volatile("s_waitcnt vmcnt(0)" ::: "memory");
            const unsigned og = xb_add(&bar[XB_TOP], 1u);
            const unsigned tg = og / nx;
            if (og + 1u == (tg + 1u) * nx) xb_add(&bar[XB_TOPGEN], 1u);
            else XB_SPIN(xb_ld(&bar[XB_TOPGEN]) == tg, bar);
            __builtin_amdgcn_fence(__ATOMIC_ACQUIRE, "agent");
            asm volatile("s_waitcnt vmcnt(0)" ::: "memory");
        } else {
            XB_SPIN(xb_ld(&bar[XB_TOPGEN]) == gen, bar);
            __builtin_amdgcn_fence(__ATOMIC_ACQUIRE, "agent");
            asm volatile("s_waitcnt vmcnt(0)" ::: "memory");
        }
    }
    __syncthreads();
}

#ifndef ECHO_MASK
#define ECHO_MASK 0u
#endif
#define PH_DONE(cls) do { if (ECHO_MASK) { const unsigned long long t_ = __builtin_amdgcn_s_memrealtime(); if (ECHO_MASK & (1u << (cls))) echo_ += t_ - tprev_; tprev_ = t_; } } while (0)
__global__ void __launch_bounds__(512, 2) mega_fwd(Args a) {
    extern __shared__ __attribute__((aligned(16))) unsigned char lds_raw[];
    LAS unsigned char* lds = (LAS unsigned char*)lds_raw;
    cg::grid_group grid = cg::this_grid();
    const int tid = threadIdx.x, lane = tid & 63, wave = __builtin_amdgcn_readfirstlane(tid >> 6);
    const int G = gridDim.x, bx = blockIdx.x;
    const int gw = bx * 8 + wave, NGW = G * 8;
    unsigned char* ws = a.ws;
    float* ssqx = (float*)(ws + WS_SSQX); float* ssqq = (float*)(ws + WS_SSQQ); float* ssqkv = (float*)(ws + WS_SSQKV); float* lnst = (float*)(ws + WS_LNST);
    float* cst = (float*)(ws + WS_COS); float* snt = (float*)(ws + WS_SIN);
    bf16_t* KR = (bf16_t*)(ws + WS_KR); bf16_t* WSP = (bf16_t*)(ws + WS_WSP);
    bf16_t* XB = (bf16_t*)(ws + WS_XB);
    unsigned char* hb = ws + WS_HB; unsigned char* wa = ws + WS_WA; unsigned char* wb = ws + WS_WB;
    bf16_t* HB = (bf16_t*)hb;
    bf16_t* LAT = (bf16_t*)(hb + HB_LAT); bf16_t* QN = (bf16_t*)(hb + HB_QN); bf16_t* QR = (bf16_t*)(hb + HB_QR); bf16_t* KN = (bf16_t*)(hb + HB_KN); bf16_t* VT = (bf16_t*)(hb + HB_VT);
    bf16_t* UB = (bf16_t*)(hb + HB_U); bf16_t* VTS = (bf16_t*)(hb + HB_VTS);
    float* X32 = a.out;
    LAS float* scr = (LAS float*)(lds + wave * 16384);
    volatile LAS unsigned* MISC = (volatile LAS unsigned*)(lds + 131072);
    if (tid < 64) MISC[tid] = 0u;
    unsigned* ctl = (unsigned*)(ws + WS_CTL);
    if (bx == 0) for (int i = tid; i < 8192; i += 512) __hip_atomic_store(ctl + i, 0u, __ATOMIC_RELAXED, __HIP_MEMORY_SCOPE_AGENT);
    __syncthreads();

    unsigned long long tprev_ = ECHO_MASK ? __builtin_amdgcn_s_memrealtime() : 0ull, echo_ = 0ull;
    conv_set_a(a, 0, scr, gw, NGW, lane);
    for (int i = gw * 64 + lane; i < 2 * 8 * 128 * 128; i += NGW * 64) { const int s = i & 127, t = (i >> 7) & 127; WSP[i] = (bf16_t)(cvt_pk_bf16(s <= t ? a.w_sp[i] : 0.f, 0.f) & 0xffffu); }
    for (int i = gw * 64 + lane; i < M * 32; i += NGW * 64) { const int tok = i >> 5, fi = i & 31;
        const float inv_freq = exp2f(-(float)(2 * fi) * (13.287712379549449f / 64.0f));
        const float ang = (float)a.pos[tok] * inv_freq;
        const double rev = (double)ang * 0.15915494309189535; const float fr = (float)(rev - __builtin_rint(rev));
        cst[i] = __builtin_amdgcn_cosf(fr); snt[i] = __builtin_amdgcn_sinf(fr); }
    for (int m0 = gw * 4; m0 < M; m0 += NGW * 4) {
        f32x4 xv[4][4];
#pragma unroll
        for (int q = 0; q < 4; ++q) { const f32x4* xr = (const f32x4*)(a.x + (size_t)(m0 + q) * DM) + lane;
#pragma unroll
            for (int jj = 0; jj < 4; ++jj) xv[q][jj] = xr[64 * jj]; }
#pragma unroll
        for (int q = 0; q < 4; ++q) { const int m = m0 + q;
#pragma unroll
            for (int jj = 0; jj < 4; ++jj) { const f32x4 v = xv[q][jj]; float s = dot4(v);
                u32x2 w; w.x = cvt_pk_bf16(v[0], v[1]); w.y = cvt_pk_bf16(v[2], v[3]);
                *(u32x2*)(XB + (size_t)m * DM + 256 * jj + 4 * lane) = w;
                s += __shfl_xor(s, 1); s += __shfl_xor(s, 2); s += __shfl_xor(s, 4); s += __shfl_xor(s, 8);
                if ((lane & 15) == 0) ssqx[(size_t)m * 16 + 4 * jj + (lane >> 4)] = s; } }
    }
    grid.sync(); PH_DONE(0);
    const XcdBarrier xbar = xcd_barrier_post(ctl, MISC + 8);
    if (tid == 0) { MISC[16] = xb_add(ctl + 3400 + xbar.x, 1u); MISC[17] = xbar.x; }
    int vb = bx;

    for (int L = 0; L < 4; ++L) {
        const int j = L >> 1;
        if ((L & 1) == 0) {
            { pg8::Gemm g{XB, (const bf16_t*)(wa + WA_LAT), M, 512, 1024, 1024, 1024, 1 << 30, 0, 0}; pg8::StaticOrder S; S.init(M, 512, G, vb);
              EpiLat E{LAT, KR, ssqx, ssqq, ssqkv, cst, snt};
              pg8::gemm_phase(lds, g, S, E); }
            { const int nidle = G - 128;
              if (nidle >= 64) { if (vb >= 128) conv_set_b(a, j, scr, (vb - 128) * 8 + wave, nidle * 8, lane); }
              else conv_set_b(a, j, scr, gw, NGW, lane); }
            xcd_barrier(xbar); PH_DONE(1);
            if (L == 0) {
                if (tid == 0) { bool ok = (G % 8) == 0;
                    for (int q = 0; q < 16; ++q) ok = ok && (xb_ld(ctl + 3400 + q) == (q < 8 ? (unsigned)(G / 8) : 0u));
                    MISC[18] = ok ? (MISC[16] * 8u + MISC[17]) : (unsigned)bx; }
                __syncthreads();
                vb = __builtin_amdgcn_readfirstlane((int)MISC[18]);
            }
            { pg8::Gemm g{LAT, (const bf16_t*)(wa + WA_QK), M, 2560, 256, LATK, LATK, 6, 256, 128};    pg8::StaticOrder S; S.init(M, 2560, G, vb);
              EpiQK E{QN, QR, KN, ssqq, ssqkv, cst, snt};
              pg8::gemm_phase(lds, g, S, E); }
            { pg8::Gemm g{(const bf16_t*)(wa + WA_V) + 256, LAT + 256, 1024, M, 128, LATK, LATK, 1 << 30, 0, 0};    pg8::StaticOrder S; S.init(1024, M, G, vb);
              EpiVT E{VT, ssqkv};
              pg8::gemm_phase(lds, g, S, E); }
            xcd_barrier(xbar); PH_DONE(2);
            { const int nsl = (G == 256) ? 1 : 0;
              for (int p0 = vb; p0 < 256; p0 += G) {
                  const int p = nsl ? ((p0 & 7) * 32 + (p0 >> 3)) : p0;
                  const int bh = p >> 3, pi = p & 7;
                  att::attn_unit(lds, bh >> 3, bh & 7, 15 - pi, QN, QR, KN, KR, VT, QN);
                  att::attn_unit(lds, bh >> 3, bh & 7, pi, QN, QR, KN, KR, VT, QN);
              }
              __syncthreads(); }
            xcd_barrier(xbar); PH_DONE(3);
            { pg8::Gemm g{QN, (const bf16_t*)(wa + WA_O), M, 1024, 1024, 1024, 1024, 1 << 30, 0, 0}; pg8::StaticOrder S; S.init(M, 1024, G, vb);
              EpiRes E{XB, ssqx};
              pg8::gemm_phase(lds, g, S, E); }
            xcd_barrier(xbar); PH_DONE(4);
        } else {
            { pg8::Gemm g{XB, (const bf16_t*)(wb + WB_INU), M, SGW, 1024, 1024, 1024, 1 << 30, 0, 0}; pg8::StaticOrder S; S.init(M, SGW, G, vb);
              EpiU E{UB, ssqx};
              pg8::gemm_phase(lds, g, S, E); }
            { pg8::Gemm g{(const bf16_t*)(wb + WB_INV), XB, SGW, M, 1024, 1024, 1024, 1 << 30, 0, 0}; pg8::StaticOrder S; S.init(SGW, M, G, vb);
              EpiVTS E{VTS, ssqx, lnst};
              pg8::gemm_phase(lds, g, S, E); }
            xcd_barrier(xbar); PH_DONE(5);
            { const bf16_t* wsp = WSP + (size_t)j * 8 * 128 * 128; const float* bsp = a.b_sp + j * 8 * 128;
              sgu::phase(lds, G, vb, VTS, lnst, a.ln_g + j * SGW, a.ln_b + j * SGW, wsp, bsp, UB); }
            if (L == 1) conv_set_a(a, 1, scr, gw, NGW, lane);
            xcd_barrier(xbar); PH_DONE(6);
            { pg8::Gemm g{UB, (const bf16_t*)(wb + WB_OUT), M, 1024, SGW, SGW, SGW, 1 << 30, 0, 0}; pg8::StaticOrder S; S.init(M, 1024, G, vb);
              EpiRes E{XB, ssqx};
              pg8::gemm_phase(lds, g, S, E); }
            xcd_barrier(xbar); PH_DONE(7);
        }
        unsigned char* wl = (L & 1) ? wb : wa;
        const size_t off_up = (L & 1) ? WB_UP : WA_UP, off_dn = (L & 1) ? WB_DN : WA_DN;
        { pg8::Gemm g{XB, (const bf16_t*)(wl + off_up), M, FF, 1024, 1024, 1024, 1 << 30, 0, 0}; pg8::StaticOrder S; S.init(M, FF, G, vb);
          EpiUp E{HB, ssqx};
          pg8::gemm_phase(lds, g, S, E); }
        xcd_barrier(xbar); PH_DONE(8);
        { pg8::Gemm g{HB, (const bf16_t*)(wl + off_dn), M, 1024, FF, FF, FF, 1 << 30, 0, 0}; pg8::StaticOrder S; S.init(M, 1024, G, vb);
          if (L == 3 && G == 256) {
              EpiResFinal E{XB, X32, ssqx, ctl + 4096, a.final_norm};
              pg8::gemm_phase(lds, g, S, E);
          } else {
              EpiRes E{XB, ssqx};
              pg8::gemm_phase(lds, g, S, E); } }
        if (!(L == 3 && G == 256)) { xcd_barrier(xbar); PH_DONE(9); }
    }
    int lt2_ = threadIdx.x; asm volatile("" : "+v"(lt2_)); const int lane2 = lt2_ & 63;
    if (G != 256)
    for (int m0 = gw * 4; m0 < M; m0 += NGW * 4) {
        u32x4 raw[4][2];
#pragma unroll
        for (int q = 0; q < 4; ++q) { const u32x4* xr = (const u32x4*)(XB + (size_t)(m0 + q) * DM) + lane2; raw[q][0] = xr[0]; raw[q][1] = xr[64]; }
        const f32x4 g00 = *(const f32x4*)(a.final_norm + 8 * lane2), g01 = *(const f32x4*)(a.final_norm + 8 * lane2 + 4);
        const f32x4 g10 = *(const f32x4*)(a.final_norm + 512 + 8 * lane2), g11 = *(const f32x4*)(a.final_norm + 512 + 8 * lane2 + 4);
#pragma unroll
        for (int q = 0; q < 4; ++q) { const int m = m0 + q;
            float v[16]; float s = 0.f;
#pragma unroll
            for (int jj = 0; jj < 2; ++jj) { const u32x4 o = raw[q][jj];
#pragma unroll
                for (int e = 0; e < 4; ++e) { v[8 * jj + 2 * e] = __builtin_bit_cast(float, o[e] << 16); v[8 * jj + 2 * e + 1] = __builtin_bit_cast(float, o[e] & 0xffff0000u); } }
#pragma unroll
            for (int e = 0; e < 16; ++e) s += v[e] * v[e];
            const float r = 1.0f / sqrtf(wave_sum(s) * (1.0f / 1024.0f) + NORM_EPS);
            float* op = X32 + (size_t)m * DM + 8 * lane2;
            *(f32x4*)op = (f32x4){v[0] * r * g00[0], v[1] * r * g00[1], v[2] * r * g00[2], v[3] * r * g00[3]};
            *(f32x4*)(op + 4) = (f32x4){v[4] * r * g01[0], v[5] * r * g01[1], v[6] * r * g01[2], v[7] * r * g01[3]};
            *(f32x4*)(op + 512) = (f32x4){v[8] * r * g10[0], v[9] * r * g10[1], v[10] * r * g10[2], v[11] * r * g10[3]};
            *(f32x4*)(op + 516) = (f32x4){v[12] * r * g11[0], v[13] * r * g11[1], v[14] * r * g11[2], v[15] * r * g11[3]}; }
    }
    if (ECHO_MASK) { PH_DONE(10); if (bx == 0 && tid < 64) { const unsigned long long t0_ = __builtin_amdgcn_s_memrealtime(); while (__builtin_amdgcn_s_memrealtime() - t0_ < echo_) __builtin_amdgcn_s_sleep(8); } }
}

extern "C" void kernel_launch(void* const* d_in, const int* in_sizes, int n_in, void* d_out, int out_size, void* d_ws, size_t ws_size, hipStream_t stream) {
    static int grid = 0;
    if (grid == 0) {
        if (n_in != 19 || out_size != M * DM || ws_size < WS_END) { fprintf(stderr, "kernel_launch: unexpected shapes (n_in %d out %d ws %zu)\n", n_in, out_size, ws_size); grid = -1; return; }
        int dev = 0, cus = 0, per_cu = 0;
        hipGetDevice(&dev); hipDeviceGetAttribute(&cus, hipDeviceAttributeMultiprocessorCount, dev);
        hipFuncSetAttribute((const void*)mega_fwd, hipFuncAttributeMaxDynamicSharedMemorySize, LDS_BYTES);
        hipOccupancyMaxActiveBlocksPerMultiprocessor(&per_cu, (const void*)mega_fwd, 512, LDS_BYTES);
        if (per_cu < 1) { fprintf(stderr, "kernel_launch: occupancy query returned %d\n", per_cu); per_cu = 1; }
        grid = cus * per_cu;
    }
    if (grid < 0) return;
    Args a{};
    a.x = (const float*)d_in[0]; a.pos = (const int*)d_in[1]; a.norm_mix = (const float*)d_in[2]; a.norm_ffn = (const float*)d_in[3]; a.final_norm = (const float*)d_in[4];
    a.w_dkv = (const float*)d_in[5]; a.q_norm = (const float*)d_in[6]; a.kv_norm = (const float*)d_in[7]; a.w_uq = (const float*)d_in[8]; a.w_ukv = (const float*)d_in[9]; a.w_o = (const float*)d_in[10];
    a.w_in = (const float*)d_in[11]; a.ln_g = (const float*)d_in[12]; a.ln_b = (const float*)d_in[13]; a.w_sp = (const float*)d_in[14]; a.b_sp = (const float*)d_in[15]; a.w_out = (const float*)d_in[16];
    a.w_up = (const float*)d_in[17]; a.w_down = (const float*)d_in[18];
    a.out = (float*)d_out; a.ws = (unsigned char*)d_ws;
    void* args[] = {&a};
    hipError_t e = hipLaunchCooperativeKernel((const void*)mega_fwd, dim3(grid), dim3(512), args, LDS_BYTES, stream);
    if (e != hipSuccess) fprintf(stderr, "cooperative launch failed: %s (grid %d)\n", hipGetErrorString(e), grid);
}
```

```cpp
#include <hip/hip_runtime.h>
#include <hip/hip_cooperative_groups.h>
#include <cstdio>
#include <cstdint>
namespace cg = cooperative_groups;

#define LAS __attribute__((address_space(3)))
typedef unsigned short bf16_t;
typedef short bf16x8 __attribute__((ext_vector_type(8)));
typedef float f32x4 __attribute__((ext_vector_type(4)));
typedef float f32x2 __attribute__((ext_vector_type(2)));
typedef float f32x16 __attribute__((ext_vector_type(16)));
typedef unsigned u32x4 __attribute__((ext_vector_type(4)));
typedef unsigned u32x2 __attribute__((ext_vector_type(2)));

constexpr int M = 16384, DM = 1024, SEQ = 4096, NH = 8, FF = 4096, SGW = 2048;
constexpr int LATK = 384;
constexpr float NORM_EPS = 1e-6f, LN_EPS = 1e-5f;
constexpr float QSCALE = 0.07216878364870322f * 1.4426950408889634f;

constexpr size_t MiB = 1u << 20;
constexpr size_t WS_SSQX = 0;
constexpr size_t WS_SSQQ = 1 * MiB;
constexpr size_t WS_SSQKV = 1 * MiB + 256 * 1024;
constexpr size_t WS_LNST = 2 * MiB;
constexpr size_t WS_COS = 4 * MiB, WS_SIN = 6 * MiB;
constexpr size_t WS_KR = 8 * MiB;
constexpr size_t WS_WSP = 10 * MiB;
constexpr size_t WS_CTL = 12 * MiB;
constexpr size_t WS_WA = 16 * MiB;
constexpr size_t WA_LAT = 0, WA_QK = 1 * MiB, WA_V = 3 * MiB, WA_O = 4 * MiB, WA_UP = 6 * MiB, WA_DN = 14 * MiB;
constexpr size_t WS_WB = 40 * MiB;
constexpr size_t WB_INU = 0, WB_INV = 4 * MiB, WB_OUT = 8 * MiB, WB_UP = 12 * MiB, WB_DN = 20 * MiB;
constexpr size_t WS_XB = 72 * MiB;
constexpr size_t WS_HB = 104 * MiB;
constexpr size_t HB_LAT = 0, HB_QN = 16 * MiB, HB_QR = 48 * MiB, HB_KN = 64 * MiB, HB_VT = 96 * MiB;
constexpr size_t HB_U = 0, HB_VTS = 64 * MiB;
constexpr size_t WS_END = 232 * MiB;

constexpr int LDS_BYTES = 147456;

__device__ __forceinline__ unsigned cvt_pk_bf16(float lo, float hi) { unsigned r; asm volatile("v_cvt_pk_bf16_f32 %0, %1, %2" : "=v"(r) : "v"(lo), "v"(hi)); return r; }
__device__ __forceinline__ float bf2f(unsigned short b) { return __builtin_bit_cast(float, (unsigned)b << 16); }
__device__ __forceinline__ u32x4 pack8(f32x4 a, f32x4 b) { u32x4 w; w.x = cvt_pk_bf16(a[0], a[1]); w.y = cvt_pk_bf16(a[2], a[3]); w.z = cvt_pk_bf16(b[0], b[1]); w.w = cvt_pk_bf16(b[2], b[3]); return w; }
__device__ __forceinline__ float sum4(f32x4 v) { return (v[0] + v[1]) + (v[2] + v[3]); }
__device__ __forceinline__ float dot4(f32x4 v) { return (v[0] * v[0] + v[1] * v[1]) + (v[2] * v[2] + v[3] * v[3]); }
__device__ __forceinline__ f32x2 gelu_pk(f32x2 v) {
    f32x2 a; a.x = fminf(__builtin_fabsf(v.x), 7.0f); a.y = fminf(__builtin_fabsf(v.y), 7.0f);
    f32x2 g = a * 2.993315796e-05f + (-7.399407552e-04f);
    g = g * a + 7.977643783e-03f; g = g * a + (-5.323840914e-02f); g = g * a + (-4.589155654e-01f); g = g * a + (-1.151147105e+00f); g = g * a + (-1.0f);
    f32x2 t; t.x = __builtin_amdgcn_exp2f(g.x); t.y = __builtin_amdgcn_exp2f(g.y);
    f32x2 o; o.x = fmaxf(v.x, 0.f) - __builtin_fabsf(v.x) * t.x; o.y = fmaxf(v.y, 0.f) - __builtin_fabsf(v.y) * t.y; return o;
}
__device__ __forceinline__ f32x4 gelu4(f32x4 v) { f32x2 a = gelu_pk((f32x2){v[0], v[1]}), b = gelu_pk((f32x2){v[2], v[3]}); return (f32x4){a.x, a.y, b.x, b.y}; }

namespace pg8 {
constexpr int BM = 256, BK = 64, HALF = 128, HTB = HALF * BK * 2, STAGE_BYTES = 8 * HTB, NXCD = 8, WGM = 4;
__device__ __forceinline__ int lds_byte(int r, int c) { const int st = (r >> 4) * 2 + (c >> 5), rr = r & 15, cc = c & 31, ob = rr * 64 + cc * 2; return st * 1024 + (ob ^ (((ob >> 9) & 1) << 5)); }
__device__ __forceinline__ void stage_rc(int b, int& R, int& C) { const int st = b / 1024, sb = b % 1024, swz = sb ^ (((sb >> 9) & 1) << 5); R = (st >> 1) * 16 + swz / 64; C = (st & 1) * 32 + (swz % 64) / 2; }
__device__ __forceinline__ int perm32(int rho) { const int n = rho >> 4, i = rho & 15; return 8 * (i >> 2) + 4 * n + (i & 3); }

struct Unit { int pm, pn; };
struct Gemm { const bf16_t* A; const bf16_t* Bt; int M, N, K, lda, ldb; int split_pn, kofs2, K2; };

struct StaticOrder {
    int nM, nN, nwg, G, c;
    __device__ void init(int M_, int N_, int G_, int c_) { asm volatile("" : "+s"(G_), "+s"(c_)); nM = M_ / BM; nN = N_ / BM; nwg = nM * nN; G = G_; c = c_; }
    __device__ bool next(int i, Unit& u) const {
        const long L = (long)i * G + c; if (L >= nwg) return false;
        int wgid = (int)L; { const int q = nwg / NXCD, r = nwg % NXCD, xcd = wgid % NXCD, off = wgid / NXCD; wgid = (xcd < r ? xcd * (q + 1) : r * (q + 1) + (xcd - r) * q) + off; }
        const int nig = WGM * nN, gid = wgid / nig, fm = gid * WGM, gsz = (nM - fm) < WGM ? (nM - fm) : WGM;
        u.pm = fm + ((wgid % nig) % gsz); u.pn = (wgid % nig) / gsz; return true;
    }
};

template <class Epi, class Sched>
__device__ __forceinline__ void gemm_phase(LAS unsigned char* lds, const Gemm g, const Sched& S, const Epi& E) {
    int tid_ = threadIdx.x; asm volatile("" : "+v"(tid_));
    const int tid = tid_, wid = __builtin_amdgcn_readfirstlane(tid >> 6), lane = tid & 63, wr = wid >> 2, wc = wid & 3, fr = lane & 15, fq = lane >> 4;
    int nt_ = g.K / BK; asm volatile("" : "+s"(nt_)); const int nt1 = nt_, nt2 = g.K2 / BK;
    unsigned voffA[2], voffB[2];
#pragma unroll
    for (int i = 0; i < 2; ++i) { int R, C; stage_rc(tid * 16 + i * 8192, R, C); const int Rb = (R & ~31) + perm32(R & 31);
        voffA[i] = (unsigned)(R * g.lda + C) * 2u; voffB[i] = (unsigned)(Rb * g.ldb + C) * 2u; }
    const size_t kstep = (size_t)(BK * 2);
    const size_t hA = (size_t)HALF * g.lda * 2, hB = (size_t)HALF * g.ldb * 2, tA = 2 * hA, tB = 2 * hB;
    const unsigned ldsw = (unsigned)wid * 1024u;
    const int aoff = lds_byte(wr * 64 + fr, fq * 8), boff = lds_byte(wc * 32 + fr, fq * 8);
#define PG8_SA(b, h) (((b) * 2 + (h)) * HTB)
#define PG8_SB(b, h) ((4 + (b) * 2 + (h)) * HTB)
#define PG8_STAGE(bufoff, gbase, voff) do { _Pragma("unroll") for (int _i = 0; _i < 2; ++_i) \
        __builtin_amdgcn_global_load_lds((const unsigned*)((const char*)(gbase) + (voff)[_i]), (LAS unsigned*)(lds + (bufoff) + ldsw + _i * 8192), 16, 0, 0); } while (0)
#define PG8_LDA(dst, b, h) do { _Pragma("unroll") for (int m = 0; m < 4; ++m) _Pragma("unroll") for (int k = 0; k < 2; ++k) dst[m][k] = *(const LAS bf16x8*)(lds + PG8_SA(b, h) + aoff + m * 2048 + k * 1024); } while (0)
#define PG8_LDB(dst, b, h) do { _Pragma("unroll") for (int n = 0; n < 2; ++n) _Pragma("unroll") for (int k = 0; k < 2; ++k) dst[n][k] = *(const LAS bf16x8*)(lds + PG8_SB(b, h) + boff + n * 2048 + k * 1024); } while (0)
#define PG8_MMA(ai, bj, At, Bt) do { __builtin_amdgcn_s_setprio(1); _Pragma("unroll") for (int m = 0; m < 4; ++m) _Pragma("unroll") for (int n = 0; n < 2; ++n) _Pragma("unroll") for (int k = 0; k < 2; ++k) \
        acc[ai][bj][m][n] = __builtin_amdgcn_mfma_f32_16x16x32_bf16(Bt[n][k], At[m][k], acc[ai][bj][m][n], 0, 0, 0); __builtin_amdgcn_s_setprio(0); } while (0)
#define PG8_WAIT_V(n) asm volatile("s_waitcnt vmcnt(" #n ")" ::: "memory")
#define PG8_WAIT_L(n) asm volatile("s_waitcnt lgkmcnt(" #n ")" ::: "memory")
#define PG8_BAR __builtin_amdgcn_s_barrier()
#define PG8_SCHED __builtin_amdgcn_sched_barrier(0)
    Unit cur, nxt; int ui = 0;
    if (!S.next(0, cur)) return;
    f32x4 acc[2][2][4][2];
#pragma unroll
    for (int a = 0; a < 2; ++a)
#pragma unroll
        for (int b = 0; b < 2; ++b)
#pragma unroll
            for (int m = 0; m < 4; ++m)
#pragma unroll
                for (int n = 0; n < 2; ++n) acc[a][b][m][n] = (f32x4){0.f, 0.f, 0.f, 0.f};
    bf16x8 At[4][2], B0[2][2], B1[2][2];
    const size_t ko2 = (size_t)g.kofs2 * 2;
    const char* cA = (const char*)g.A + (size_t)cur.pm * tA + (cur.pn >= g.split_pn ? ko2 : 0); const char* cB = (const char*)g.Bt + (size_t)cur.pn * tB + (cur.pn >= g.split_pn ? ko2 : 0);
    PG8_STAGE(PG8_SB(0, 0), cB, voffB); PG8_STAGE(PG8_SB(0, 1), cB + hB, voffB); PG8_STAGE(PG8_SA(0, 0), cA, voffA); PG8_STAGE(PG8_SA(0, 1), cA + hA, voffA);
    if (wr == 1) PG8_BAR;
    PG8_WAIT_V(2); PG8_BAR;
    PG8_STAGE(PG8_SB(1, 0), cB + kstep, voffB); PG8_STAGE(PG8_SA(1, 0), cA + kstep, voffA); PG8_STAGE(PG8_SB(1, 1), cB + hB + kstep, voffB);
    PG8_WAIT_V(6); PG8_BAR;
    for (;;) {
        const bool has_next = S.next(ui + 1, nxt);
        const size_t nko = (has_next && nxt.pn >= g.split_pn) ? ko2 : 0;
        const char* nA = has_next ? (const char*)g.A + (size_t)nxt.pm * tA + nko : cA; const char* nB = has_next ? (const char*)g.Bt + (size_t)nxt.pn * tB + nko : cB;
        const int nt = cur.pn >= g.split_pn ? nt2 : nt1;
#pragma unroll 1
        for (int t = 0; t < nt; t += 2) {
            const bool last = (t == nt - 2);
            const char* a1 = cA + (size_t)(t + 1) * kstep;
            const char* a2 = last ? nA : cA + (size_t)(t + 2) * kstep; const char* b2 = last ? nB : cB + (size_t)(t + 2) * kstep;
            const char* a3 = a2 + kstep; const char* b3 = b2 + kstep;
            PG8_LDB(B0, 0, 0); PG8_LDB(B1, 0, 1); PG8_SCHED; PG8_LDA(At, 0, 0); PG8_STAGE(PG8_SA(1, 1), a1 + hA, voffA);
            PG8_WAIT_V(8); PG8_WAIT_L(0); PG8_BAR; PG8_MMA(0, 0, At, B0); PG8_MMA(0, 1, At, B1); PG8_BAR; PG8_SCHED;
            PG8_LDA(At, 0, 1); PG8_STAGE(PG8_SB(0, 0), b2, voffB); PG8_STAGE(PG8_SB(0, 1), b2 + hB, voffB); PG8_STAGE(PG8_SA(0, 0), a2, voffA);
            PG8_WAIT_V(8); PG8_WAIT_L(0); PG8_BAR; PG8_MMA(1, 0, At, B0); PG8_MMA(1, 1, At, B1); PG8_BAR; PG8_SCHED;
            PG8_LDB(B0, 1, 0); PG8_LDB(B1, 1, 1); PG8_SCHED; PG8_LDA(At, 1, 0); PG8_STAGE(PG8_SA(0, 1), a2 + hA, voffA);
            PG8_WAIT_V(8); PG8_WAIT_L(0); PG8_BAR; PG8_MMA(0, 0, At, B0); PG8_MMA(0, 1, At, B1); PG8_BAR; PG8_SCHED;
            PG8_LDA(At, 1, 1); PG8_STAGE(PG8_SB(1, 0), b3, voffB); PG8_STAGE(PG8_SB(1, 1), b3 + hB, voffB); PG8_STAGE(PG8_SA(1, 0), a3, voffA);
            PG8_WAIT_V(8); PG8_WAIT_L(0); PG8_BAR; PG8_MMA(1, 0, At, B0); PG8_MMA(1, 1, At, B1); PG8_BAR; PG8_SCHED;
        }
        if (wr == 0) PG8_BAR;
        E(acc, cur, wr, wc, fr, fq);
        if (!has_next) break;
#pragma unroll
        for (int a = 0; a < 2; ++a)
#pragma unroll
            for (int b = 0; b < 2; ++b)
#pragma unroll
                for (int m = 0; m < 4; ++m)
#pragma unroll
                    for (int n = 0; n < 2; ++n) acc[a][b][m][n] = (f32x4){0.f, 0.f, 0.f, 0.f};
        cur = nxt; cA = nA; cB = nB; ++ui;
        if (wr == 1) PG8_BAR;
    }
    PG8_WAIT_V(0);
    PG8_BAR;
#undef PG8_SA
#undef PG8_SB
#undef PG8_STAGE
#undef PG8_LDA
#undef PG8_LDB
#undef PG8_MMA
#undef PG8_WAIT_V
#undef PG8_WAIT_L
#undef PG8_BAR
#undef PG8_SCHED
}
}

typedef f32x4 Acc[2][2][4][2];

__device__ __forceinline__ float row_rx(const float* ssq, int row, int fq) {
    float s = sum4(*(const f32x4*)(ssq + (size_t)row * 16 + 4 * fq));
    s += __shfl_xor(s, 16); s += __shfl_xor(s, 32);
    return 1.0f / sqrtf(s * (1.0f / 1024.0f) + NORM_EPS);
}

__device__ __forceinline__ void rows_rx(const float* ssq, int row0, int fq, float (&r)[8]) {
    f32x4 v[8];
#pragma unroll
    for (int i = 0; i < 8; ++i) v[i] = *(const f32x4*)(ssq + (size_t)(row0 + (i >> 2) * 128 + (i & 3) * 16) * 16 + 4 * fq);
#pragma unroll
    for (int i = 0; i < 8; ++i) { float s = sum4(v[i]); s += __shfl_xor(s, 16); s += __shfl_xor(s, 32); r[i] = 1.0f / sqrtf(s * (1.0f / 1024.0f) + NORM_EPS); }
    asm volatile("" ::: "memory");
}
struct EpiUp {
    bf16_t* O; const float* ssq;
    __device__ __forceinline__ void operator()(const Acc& acc, const pg8::Unit& u, int wr, int wc, int fr, int fq) const {
        const int row0 = u.pm * 256 + wr * 64 + fr, col0 = u.pn * 256 + wc * 32 + 8 * fq;
        float rr[8]; rows_rx(ssq, row0, fq, rr);
#pragma unroll
        for (int ai = 0; ai < 2; ++ai)
#pragma unroll
            for (int m = 0; m < 4; ++m) { const int row = row0 + ai * 128 + m * 16; const float r = rr[ai * 4 + m];
#pragma unroll
                for (int bj = 0; bj < 2; ++bj) { f32x4 v0 = acc[ai][bj][m][0] * r, v1 = acc[ai][bj][m][1] * r;
                    v0 = __builtin_elementwise_max(v0, (f32x4){0.f, 0.f, 0.f, 0.f}); v1 = __builtin_elementwise_max(v1, (f32x4){0.f, 0.f, 0.f, 0.f});
                    *(u32x4*)(O + (size_t)row * FF + col0 + bj * 128) = pack8(v0 * v0, v1 * v1); } asm volatile("" ::: "memory"); }
    }
};
struct EpiU {
    bf16_t* O; const float* ssq;
    __device__ __forceinline__ void operator()(const Acc& acc, const pg8::Unit& u, int wr, int wc, int fr, int fq) const {
        const int row0 = u.pm * 256 + wr * 64 + fr, col0 = u.pn * 256 + wc * 32 + 8 * fq;
        float rr[8]; rows_rx(ssq, row0, fq, rr);
#pragma unroll
        for (int ai = 0; ai < 2; ++ai)
#pragma unroll
            for (int m = 0; m < 4; ++m) { const int row = row0 + ai * 128 + m * 16; const float r = rr[ai * 4 + m];
#pragma unroll
                for (int bj = 0; bj < 2; ++bj) { const f32x4 v0 = gelu4(acc[ai][bj][m][0] * r), v1 = gelu4(acc[ai][bj][m][1] * r);
                    *(u32x4*)(O + (size_t)row * SGW + col0 + bj * 128) = pack8(v0, v1); } asm volatile("" ::: "memory"); }
    }
};
struct EpiRes {
    bf16_t* xb; float* ssq;
    __device__ __forceinline__ void operator()(const Acc& acc, const pg8::Unit& u, int wr, int wc, int fr, int fq) const {
        const int row0 = u.pm * 256 + wr * 64 + fr, col0 = u.pn * 256 + wc * 32 + 8 * fq;
#pragma unroll
        for (int ai = 0; ai < 2; ++ai) {
            u32x4 old[4][2];
#pragma unroll
            for (int m = 0; m < 4; ++m)
#pragma unroll
                for (int bj = 0; bj < 2; ++bj) old[m][bj] = *(const u32x4*)(xb + (size_t)(row0 + ai * 128 + m * 16) * DM + col0 + bj * 128);
            asm volatile("" ::: "memory");
#pragma unroll
            for (int m = 0; m < 4; ++m) { const int row = row0 + ai * 128 + m * 16; float s = 0.f;
#pragma unroll
                for (int bj = 0; bj < 2; ++bj) { const size_t p = (size_t)row * DM + col0 + bj * 128;
                    const u32x4 o = old[m][bj];
                    f32x4 x0, x1;
                    x0[0] = __builtin_bit_cast(float, o.x << 16); x0[1] = __builtin_bit_cast(float, o.x & 0xffff0000u); x0[2] = __builtin_bit_cast(float, o.y << 16); x0[3] = __builtin_bit_cast(float, o.y & 0xffff0000u);
                    x1[0] = __builtin_bit_cast(float, o.z << 16); x1[1] = __builtin_bit_cast(float, o.z & 0xffff0000u); x1[2] = __builtin_bit_cast(float, o.w << 16); x1[3] = __builtin_bit_cast(float, o.w & 0xffff0000u);
                    x0 += acc[ai][bj][m][0]; x1 += acc[ai][bj][m][1];
                    *(u32x4*)(xb + p) = pack8(x0, x1); s += dot4(x0) + dot4(x1); }
                s += __shfl_xor(s, 16); s += __shfl_xor(s, 32);
                if (fq == 0) ssq[(size_t)row * 16 + u.pn * 4 + wc] = s; }
            asm volatile("" ::: "memory");
        }
    }
};
struct EpiResFinal {
    const bf16_t* xb; float* out; float* ssq; unsigned* cnt; const float* gain;
    __device__ __forceinline__ void operator()(const Acc& acc_, const pg8::Unit& u, int wr, int wc, int fr, int fq) const {
        Acc& acc = const_cast<Acc&>(acc_);
        const int lane = threadIdx.x & 63;
        const int row0 = u.pm * 256 + wr * 64 + fr, col0 = u.pn * 256 + wc * 32 + 8 * fq;
#pragma unroll
        for (int ai = 0; ai < 2; ++ai) {
            u32x4 old[4][2];
#pragma unroll
            for (int m = 0; m < 4; ++m)
#pragma unroll
                for (int bj = 0; bj < 2; ++bj) old[m][bj] = *(const u32x4*)(xb + (size_t)(row0 + ai * 128 + m * 16) * DM + col0 + bj * 128);
            asm volatile("" ::: "memory");
#pragma unroll
            for (int m = 0; m < 4; ++m) { const int row = row0 + ai * 128 + m * 16; float s = 0.f;
#pragma unroll
                for (int bj = 0; bj < 2; ++bj) { const u32x4 o = old[m][bj];
                    f32x4 x0, x1;
                    x0[0] = __builtin_bit_cast(float, o.x << 16); x0[1] = __builtin_bit_cast(float, o.x & 0xffff0000u); x0[2] = __builtin_bit_cast(float, o.y << 16); x0[3] = __builtin_bit_cast(float, o.y & 0xffff0000u);
                    x1[0] = __builtin_bit_cast(float, o.z << 16); x1[1] = __builtin_bit_cast(float, o.z & 0xffff0000u); x1[2] = __builtin_bit_cast(float, o.w << 16); x1[3] = __builtin_bit_cast(float, o.w & 0xffff0000u);
                    x0 += acc[ai][bj][m][0]; x1 += acc[ai][bj][m][1];
                    acc[ai][bj][m][0] = x0; acc[ai][bj][m][1] = x1; s += dot4(x0) + dot4(x1); }
                s += __shfl_xor(s, 16); s += __shfl_xor(s, 32);
                if (fq == 0) __hip_atomic_store((unsigned*)(ssq + (size_t)row * 16 + u.pn * 4 + wc), __float_as_uint(s), __ATOMIC_RELAXED, __HIP_MEMORY_SCOPE_AGENT); }
            asm volatile("" ::: "memory");
        }
        asm volatile("s_waitcnt vmcnt(0)" ::: "memory");
        unsigned* c = cnt + 64 * u.pm;
        if (lane == 0) __hip_atomic_fetch_add(c, 1u, __ATOMIC_RELAXED, __HIP_MEMORY_SCOPE_AGENT);
        { unsigned sp = 0;
          while ((unsigned)__builtin_amdgcn_readfirstlane(__hip_atomic_load(c, __ATOMIC_RELAXED, __HIP_MEMORY_SCOPE_AGENT)) < 32u) { __builtin_amdgcn_s_sleep(2); if (++sp > (1u << 20)) break; } }
        __builtin_amdgcn_fence(__ATOMIC_ACQUIRE, "agent");
        float rr[8];
        { unsigned long long pv[8][2];
#pragma unroll
          for (int i = 0; i < 8; ++i) { const unsigned long long* p = (const unsigned long long*)(ssq + (size_t)(row0 + (i >> 2) * 128 + (i & 3) * 16) * 16 + 4 * fq);
              pv[i][0] = __hip_atomic_load(p, __ATOMIC_RELAXED, __HIP_MEMORY_SCOPE_AGENT); pv[i][1] = __hip_atomic_load(p + 1, __ATOMIC_RELAXED, __HIP_MEMORY_SCOPE_AGENT); }
#pragma unroll
          for (int i = 0; i < 8; ++i) { float t = (__uint_as_float((unsigned)pv[i][0]) + __uint_as_float((unsigned)(pv[i][0] >> 32))) + (__uint_as_float((unsigned)pv[i][1]) + __uint_as_float((unsigned)(pv[i][1] >> 32)));
              t += __shfl_xor(t, 16); t += __shfl_xor(t, 32); rr[i] = 1.0f / sqrtf(t * (1.0f / 1024.0f) + NORM_EPS); }
          asm volatile("" ::: "memory"); }
        f32x4 gv[2][2];
#pragma unroll
        for (int bj = 0; bj < 2; ++bj) { gv[bj][0] = *(const f32x4*)(gain + col0 + bj * 128); gv[bj][1] = *(const f32x4*)(gain + col0 + bj * 128 + 4); }
#pragma unroll
        for (int ai = 0; ai < 2; ++ai)
#pragma unroll
            for (int m = 0; m < 4; ++m) { const int row = row0 + ai * 128 + m * 16; const float r = rr[ai * 4 + m];
#pragma unroll
                for (int bj = 0; bj < 2; ++bj) { float* op = out + (size_t)row * DM + col0 + bj * 128;
                    *(f32x4*)op = acc[ai][bj][m][0] * r * gv[bj][0]; *(f32x4*)(op + 4) = acc[ai][bj][m][1] * r * gv[bj][1]; }
                asm volatile("" ::: "memory"); }
    }
};
struct EpiLat {
    bf16_t* lat; bf16_t* kr; const float* ssqx; float* ssqq; float* ssqkv; const float* cs; const float* sn;
    __device__ __forceinline__ void operator()(const Acc& acc, const pg8::Unit& u, int wr, int wc, int fr, int fq) const {
        const int row0 = u.pm * 256 + wr * 64 + fr;
        float rr[8]; rows_rx(ssqx, row0, fq, rr);
#pragma unroll
        for (int ai = 0; ai < 2; ++ai)
#pragma unroll
            for (int m = 0; m < 4; ++m) { const int row = row0 + ai * 128 + m * 16; const float r = rr[ai * 4 + m];
                const f32x4 a0 = acc[ai][0][m][0] * r, a1 = acc[ai][0][m][1] * r, b0 = acc[ai][1][m][0] * r, b1 = acc[ai][1][m][1] * r;
                if (u.pn == 0) {
                    bf16_t* o = lat + (size_t)row * LATK + wc * 32 + 8 * fq;
                    *(u32x4*)o = pack8(a0, a1); *(u32x4*)(o + 128) = pack8(b0, b1);
                    float s = dot4(a0) + dot4(a1) + dot4(b0) + dot4(b1); s += __shfl_xor(s, 16); s += __shfl_xor(s, 32);
                    if (fq == 0) ssqq[(size_t)row * 4 + wc] = s;
                } else if (wc < 2) {
                    bf16_t* o = lat + (size_t)row * LATK + 256 + wc * 32 + 8 * fq;
                    *(u32x4*)o = pack8(a0, a1); *(u32x4*)(o + 64) = pack8(b0, b1);
                    float s = dot4(a0) + dot4(a1) + dot4(b0) + dot4(b1); s += __shfl_xor(s, 16); s += __shfl_xor(s, 32);
                    if (fq == 0) { ssqkv[(size_t)row * 4 + wc] = s; ssqkv[(size_t)row * 4 + 2 + wc] = 0.f; }
                } else if (wc == 2) {
                    const float* cp = cs + (size_t)row * 32 + 8 * fq; const float* sp = sn + (size_t)row * 32 + 8 * fq;
                    const f32x4 c0 = *(const f32x4*)cp, c1 = *(const f32x4*)(cp + 4), s0 = *(const f32x4*)sp, s1 = *(const f32x4*)(sp + 4);
                    bf16_t* o = kr + (size_t)row * 64 + 8 * fq;
                    *(u32x4*)o = pack8(a0 * c0 - b0 * s0, a1 * c1 - b1 * s1);
                    *(u32x4*)(o + 32) = pack8(b0 * c0 + a0 * s0, b1 * c1 + a1 * s1);
                }
                asm volatile("" ::: "memory");
            }
    }
};
struct EpiQK {
    bf16_t* qn; bf16_t* qr; bf16_t* kn; const float* ssqq; const float* ssqkv; const float* cs; const float* sn;
    __device__ __forceinline__ void operator()(const Acc& acc, const pg8::Unit& u, int wr, int wc, int fr, int fq) const {
        const int row0 = u.pm * 256 + wr * 64 + fr;
        const bool isq = u.pn < 6;
        float rr[8];
        { const float* sp = isq ? ssqq : ssqkv; f32x4 v[8];
#pragma unroll
          for (int i = 0; i < 8; ++i) v[i] = *(const f32x4*)(sp + (size_t)(row0 + (i >> 2) * 128 + (i & 3) * 16) * 4);
#pragma unroll
          for (int i = 0; i < 8; ++i) rr[i] = (isq ? QSCALE : 1.0f) / sqrtf(sum4(v[i]) * (isq ? (1.0f / 256.0f) : (1.0f / 128.0f)) + NORM_EPS);
          asm volatile("" ::: "memory"); }
#pragma unroll
        for (int ai = 0; ai < 2; ++ai)
#pragma unroll
            for (int m = 0; m < 4; ++m) { const int row = row0 + ai * 128 + m * 16;
                const float r = rr[ai * 4 + m];
                const f32x4 a0 = acc[ai][0][m][0] * r, a1 = acc[ai][0][m][1] * r, b0 = acc[ai][1][m][0] * r, b1 = acc[ai][1][m][1] * r;
                if (u.pn < 4) {
                    bf16_t* o = qn + (size_t)row * 1024 + u.pn * 256 + wc * 32 + 8 * fq;
                    *(u32x4*)o = pack8(a0, a1); *(u32x4*)(o + 128) = pack8(b0, b1);
                } else if (u.pn < 6) {
                    const float* cp = cs + (size_t)row * 32 + 8 * fq; const float* sp = sn + (size_t)row * 32 + 8 * fq;
                    const f32x4 c0 = *(const f32x4*)cp, c1 = *(const f32x4*)(cp + 4), s0 = *(const f32x4*)sp, s1 = *(const f32x4*)(sp + 4);
                    bf16_t* o = qr + (size_t)row * 512 + ((u.pn - 4) * 4 + wc) * 64 + 8 * fq;
                    *(u32x4*)o = pack8(a0 * c0 - b0 * s0, a1 * c1 - b1 * s1);
                    *(u32x4*)(o + 32) = pack8(b0 * c0 + a0 * s0, b1 * c1 + a1 * s1);
                } else {
                    const size_t tb = ((size_t)((row >> 12) * 8 + (u.pn - 6) * 2) * 64 + ((row & 4095) >> 6)) * 8192 + (size_t)(row & 63) * 128 + wc * 32 + 8 * fq;
                    *(u32x4*)(kn + tb) = pack8(a0, a1); *(u32x4*)(kn + tb + (size_t)64 * 8192) = pack8(b0, b1);
                }
                asm volatile("" ::: "memory");
            }
    }
};
struct EpiVT {
    bf16_t* vt; const float* ssqkv;
    __device__ __forceinline__ void operator()(const Acc& acc, const pg8::Unit& u, int wr, int wc, int fr, int fq) const {
        const int lane = threadIdx.x & 63;
        const int tokb = u.pn * 256 + wc * 32 + 8 * fq;
        float rmine; { const int tok = tokb + (fr >> 3) * 128 + (fr & 7); rmine = 1.0f / sqrtf(sum4(*(const f32x4*)(ssqkv + (size_t)tok * 4)) * (1.0f / 128.0f) + NORM_EPS); }
        const int f0 = u.pm * 256 + wr * 64 + fr;
#pragma unroll
        for (int bj = 0; bj < 2; ++bj) {
            f32x4 r0, r1;
#pragma unroll
            for (int e = 0; e < 4; ++e) { r0[e] = __shfl(rmine, (lane & 48) | (bj * 8 + e)); r1[e] = __shfl(rmine, (lane & 48) | (bj * 8 + 4 + e)); }
            const int g16 = u.pn * 256 + bj * 128 + wc * 32 + (fq >> 1) * 16;
            const size_t tbase = ((size_t)((g16 >> 12) * 8) * 64 + ((g16 & 4095) >> 6)) * 8192 + (g16 & 63) + 4 * (fq & 1);
#pragma unroll
            for (int ai = 0; ai < 2; ++ai)
#pragma unroll
                for (int m = 0; m < 4; ++m) { const int f = f0 + ai * 128 + m * 16;
                    const f32x4 v0 = acc[ai][bj][m][0] * r0, v1 = acc[ai][bj][m][1] * r1;
                    bf16_t* o = vt + tbase + (size_t)(f >> 7) * (64 * 8192) + (size_t)(f & 127) * 64;
                    u32x2 w0, w1; w0.x = cvt_pk_bf16(v0[0], v0[1]); w0.y = cvt_pk_bf16(v0[2], v0[3]); w1.x = cvt_pk_bf16(v1[0], v1[1]); w1.y = cvt_pk_bf16(v1[2], v1[3]);
                    *(u32x2*)o = w0; *(u32x2*)(o + 8) = w1; asm volatile("" ::: "memory"); }
        }
    }
};
struct EpiVTS {
    bf16_t* vt; const float* ssqx; float* lnst;
    __device__ __forceinline__ void operator()(const Acc& acc, const pg8::Unit& u, int wr, int wc, int fr, int fq) const {
        const int lane = threadIdx.x & 63;
        const int tokb = u.pn * 256 + wc * 32 + 8 * fq;
        float rmine; { const int tok = tokb + (fr >> 3) * 128 + (fr & 7); const float* p = ssqx + (size_t)tok * 16;
            const float s = (sum4(*(const f32x4*)p) + sum4(*(const f32x4*)(p + 4))) + (sum4(*(const f32x4*)(p + 8)) + sum4(*(const f32x4*)(p + 12)));
            rmine = 1.0f / sqrtf(s * (1.0f / 1024.0f) + NORM_EPS); }
        const int f0 = u.pm * 256 + wr * 64 + fr;
#pragma unroll
        for (int bj = 0; bj < 2; ++bj) {
            f32x4 r0, r1;
#pragma unroll
            for (int e = 0; e < 4; ++e) { r0[e] = __shfl(rmine, (lane & 48) | (bj * 8 + e)); r1[e] = __shfl(rmine, (lane & 48) | (bj * 8 + 4 + e)); }
            f32x4 s10 = {0.f, 0.f, 0.f, 0.f}, s11 = s10, s20 = s10, s21 = s10;
            const int tok0 = tokb + bj * 128;
#pragma unroll
            for (int ai = 0; ai < 2; ++ai)
#pragma unroll
                for (int m = 0; m < 4; ++m) { const int f = f0 + ai * 128 + m * 16;
                    const f32x4 v0 = gelu4(acc[ai][bj][m][0] * r0), v1 = gelu4(acc[ai][bj][m][1] * r1);
                    *(u32x4*)(vt + (size_t)f * M + tok0) = pack8(v0, v1);
                    s10 += v0; s11 += v1; s20 += v0 * v0; s21 += v1 * v1; asm volatile("" ::: "memory"); }
#pragma unroll
            for (int o = 1; o < 16; o <<= 1) {
#pragma unroll
                for (int e = 0; e < 4; ++e) { s10[e] += __shfl_xor(s10[e], o); s11[e] += __shfl_xor(s11[e], o); s20[e] += __shfl_xor(s20[e], o); s21[e] += __shfl_xor(s21[e], o); } }
            if (fr == 0) {
                const int slot = u.pm * 2 + wr;
#pragma unroll
                for (int e = 0; e < 4; ++e) {
                    *(f32x2*)(lnst + ((size_t)(tok0 + e) * 16 + slot) * 2) = (f32x2){s10[e], s20[e]};
                    *(f32x2*)(lnst + ((size_t)(tok0 + 4 + e) * 16 + slot) * 2) = (f32x2){s11[e], s21[e]}; }
            }
        }
    }
};

namespace att {
constexpr int KROW = 200, VROW = 72, KBYTES = 64 * KROW * 2, VBYTES = 128 * VROW * 2, BUFB = KBYTES + VBYTES;
__device__ __forceinline__ int crow(int r, int hi) { return (r & 3) + 8 * (r >> 2) + 4 * hi; }
__device__ __forceinline__ float max2f(float a, float b) { float r; asm volatile("v_max_f32_e32 %0, %1, %2" : "=v"(r) : "v"(a), "v"(b)); return r; }
__device__ __forceinline__ float add2f(float a, float b) { float r; asm volatile("v_add_f32_e32 %0, %1, %2" : "=v"(r) : "v"(a), "v"(b)); return r; }
__device__ __forceinline__ float max3f(float a, float b, float c) { float r; asm("v_max3_f32 %0, %1, %2, %3" : "=v"(r) : "v"(a), "v"(b), "v"(c)); return r; }

__device__ __forceinline__ void attn_unit(LAS unsigned char* lds, int b, int h, int qb, const bf16_t* Qn, const bf16_t* Qr, const bf16_t* __restrict__ Kn,
                                          const bf16_t* __restrict__ Kr, const bf16_t* __restrict__ Vt, bf16_t* O) {
    int tid_ = threadIdx.x; asm volatile("" : "+v"(tid_));
    const int tid = tid_, lane = tid & 63, r32 = lane & 31, hi = lane >> 5, wid = __builtin_amdgcn_readfirstlane(tid >> 6);
    const int tok0 = b * SEQ, q0 = qb * 256;
    const int qtok = tok0 + q0 + wid * 32 + r32;
    bf16x8 qf[12];
#pragma unroll
    for (int ks = 0; ks < 8; ++ks) qf[ks] = *(const bf16x8*)(Qn + (size_t)qtok * 1024 + h * 128 + ks * 16 + hi * 8);
#pragma unroll
    for (int ks = 0; ks < 4; ++ks) qf[8 + ks] = *(const bf16x8*)(Qr + (size_t)qtok * 512 + h * 64 + ks * 16 + hi * 8);
    f32x16 o[4];
#pragma unroll
    for (int d = 0; d < 4; ++d)
#pragma unroll
        for (int r = 0; r < 16; ++r) o[d][r] = 0.f;
    float mrow = -INFINITY, lrow = 0.f;
    const int NT = 4 * (qb + 1);
    u32x4 st[5];
    const int krow0 = tid >> 4, kcc = tid & 15, rrow = tid >> 3, rcc = tid & 7;
    const bf16_t* kn_src = Kn + (size_t)(b * 8 + h) * (64 * 8192) + krow0 * 128 + kcc * 8;
    const bf16_t* kr_src = Kr + (size_t)(tok0 + rrow) * 64 + rcc * 8;
    const bf16_t* vt_src = Vt + (size_t)(b * 8 + h) * (64 * 8192) + rrow * 64 + rcc * 8;
#define ATT_LOAD(j) do { const size_t tb_ = (size_t)(j) * 64; \
        st[0] = *(const u32x4*)(kn_src + tb_ * 128); st[1] = *(const u32x4*)(kn_src + tb_ * 128 + 4096); \
        st[2] = *(const u32x4*)(kr_src + tb_ * 64); \
        st[3] = *(const u32x4*)(vt_src + tb_ * 128); st[4] = *(const u32x4*)(vt_src + tb_ * 128 + 4096); } while (0)
#define ATT_STORE(buf) do { LAS unsigned char* ks_ = lds + (buf) * BUFB; LAS unsigned char* vs_ = ks_ + KBYTES; \
        *(LAS u32x4*)(ks_ + (krow0 * KROW + kcc * 8) * 2) = st[0]; *(LAS u32x4*)(ks_ + ((krow0 + 32) * KROW + kcc * 8) * 2) = st[1]; \
        *(LAS u32x4*)(ks_ + (rrow * KROW + 128 + rcc * 8) * 2) = st[2]; \
        *(LAS u32x4*)(vs_ + (rrow * VROW + rcc * 8) * 2) = st[3]; *(LAS u32x4*)(vs_ + ((rrow + 64) * VROW + rcc * 8) * 2) = st[4]; } while (0)
    ATT_LOAD(0);
    for (int j = 0; j < NT; ++j) {
        const int buf = j & 1;
        ATT_STORE(buf);
        __syncthreads();
        if (j + 1 < NT) ATT_LOAD(j + 1);
        const unsigned ka = (unsigned)(uintptr_t)(lds + buf * BUFB) + (unsigned)((r32 * KROW + hi * 8) * 2);
        const unsigned va = (unsigned)(uintptr_t)(lds + buf * BUFB) + (unsigned)(KBYTES + (r32 * VROW + hi * 8) * 2);
#define DSR(dst, addr, off) asm volatile("ds_read_b128 %0, %1 offset:%2" : "=v"(dst) : "v"(addr), "n"(off) : "memory")
#define LWAIT(n, f) asm volatile("s_waitcnt lgkmcnt(" #n ")" : "+v"(f[0]), "+v"(f[1]), "+v"(f[2]), "+v"(f[3]) :: "memory")
#define KREAD(f, g) do { DSR(f[0], ka, (2 * (g)) * 32); DSR(f[1], ka, 12800 + (2 * (g)) * 32); DSR(f[2], ka, (2 * (g) + 1) * 32); DSR(f[3], ka, 12800 + (2 * (g) + 1) * 32); } while (0)
#define KMMA(f, g) do { p0 = __builtin_amdgcn_mfma_f32_32x32x16_bf16(f[0], qf[2 * (g)], p0, 0, 0, 0); p1 = __builtin_amdgcn_mfma_f32_32x32x16_bf16(f[1], qf[2 * (g)], p1, 0, 0, 0); \
                         p0 = __builtin_amdgcn_mfma_f32_32x32x16_bf16(f[2], qf[2 * (g) + 1], p0, 0, 0, 0); p1 = __builtin_amdgcn_mfma_f32_32x32x16_bf16(f[3], qf[2 * (g) + 1], p1, 0, 0, 0); } while (0)
#define VREAD(f, ks) do { DSR(f[0], va, (ks) * 32); DSR(f[1], va, 4608 + (ks) * 32); DSR(f[2], va, 9216 + (ks) * 32); DSR(f[3], va, 13824 + (ks) * 32); } while (0)
#define VMMA(f, ks) do { o[0] = __builtin_amdgcn_mfma_f32_32x32x16_bf16(f[0], pk[ks], o[0], 0, 0, 0); o[1] = __builtin_amdgcn_mfma_f32_32x32x16_bf16(f[1], pk[ks], o[1], 0, 0, 0); \
                          o[2] = __builtin_amdgcn_mfma_f32_32x32x16_bf16(f[2], pk[ks], o[2], 0, 0, 0); o[3] = __builtin_amdgcn_mfma_f32_32x32x16_bf16(f[3], pk[ks], o[3], 0, 0, 0); } while (0)
        static_assert(32 * KROW * 2 == 12800 && 32 * VROW * 2 == 4608, "fragment offsets");
        if (!(j >= NT - 4 && 64 * (j - (NT - 4)) > wid * 32 + 31)) {
        f32x16 p0, p1;
#pragma unroll
        for (int r = 0; r < 16; ++r) { p0[r] = 0.f; p1[r] = 0.f; }
        bf16x8 fa[4], fb[4];
        KREAD(fa, 0); KREAD(fb, 1);
        LWAIT(4, fa); KMMA(fa, 0); KREAD(fa, 2);
        LWAIT(4, fb); KMMA(fb, 1); KREAD(fb, 3);
        LWAIT(4, fa); KMMA(fa, 2); KREAD(fa, 4);
        LWAIT(4, fb); KMMA(fb, 3); KREAD(fb, 5);
        LWAIT(4, fa); KMMA(fa, 4); VREAD(fa, 0);
        LWAIT(4, fb); KMMA(fb, 5); VREAD(fb, 1);
        asm volatile("s_nop 15\n\ts_nop 7" : "+v"(p0), "+v"(p1));
        const int jb = j - (NT - 4);
        if (jb >= 0 && 64 * jb + 63 > wid * 32) {
            const int qrel = wid * 32 + r32, kb = 64 * jb + 4 * hi;
#pragma unroll
            for (int r = 0; r < 16; ++r) { const int kv = kb + (r & 3) + 8 * (r >> 2); if (kv > qrel) p0[r] = -INFINITY; if (kv + 32 > qrel) p1[r] = -INFINITY; }
        }
        float mxa = max3f(p0[0], p0[1], p1[0]), mxb = max3f(p0[2], p0[3], p1[1]); mxa = max3f(mxa, p1[2], p1[3]);
#pragma unroll
        for (int r = 4; r < 16; r += 4) { mxa = max3f(mxa, p0[r], p0[r + 1]); mxb = max3f(mxb, p0[r + 2], p0[r + 3]); mxa = max3f(mxa, p1[r], p1[r + 1]); mxb = max3f(mxb, p1[r + 2], p1[r + 3]); }
        float mx = fmaxf(mxa, mxb);
        { const unsigned ma = __float_as_uint(mx); const auto rr = __builtin_amdgcn_permlane32_swap(ma, ma, false, false);
          const unsigned r0 = rr[0], r1 = rr[1];
          mx = max2f(__uint_as_float(r0), __uint_as_float(r1)); }
        const float mnew = fmaxf(mrow, mx);
        const float alpha = __builtin_amdgcn_exp2f(mrow - mnew);
        mrow = mnew;
        float ls = 0.f;
#pragma unroll
        for (int r = 0; r < 16; ++r) { p0[r] = __builtin_amdgcn_exp2f(p0[r] - mnew); p1[r] = __builtin_amdgcn_exp2f(p1[r] - mnew); ls += p0[r] + p1[r]; }
        lrow = lrow * alpha + ls;
#pragma unroll
        for (int d = 0; d < 4; ++d)
#pragma unroll
            for (int r = 0; r < 16; ++r) o[d][r] *= alpha;
        bf16x8 pk[4];
        { u32x4 w;
          w.x = cvt_pk_bf16(p0[0], p0[1]); w.y = cvt_pk_bf16(p0[2], p0[3]); w.z = cvt_pk_bf16(p0[4], p0[5]); w.w = cvt_pk_bf16(p0[6], p0[7]); pk[0] = __builtin_bit_cast(bf16x8, w);
          w.x = cvt_pk_bf16(p0[8], p0[9]); w.y = cvt_pk_bf16(p0[10], p0[11]); w.z = cvt_pk_bf16(p0[12], p0[13]); w.w = cvt_pk_bf16(p0[14], p0[15]); pk[1] = __builtin_bit_cast(bf16x8, w);
          w.x = cvt_pk_bf16(p1[0], p1[1]); w.y = cvt_pk_bf16(p1[2], p1[3]); w.z = cvt_pk_bf16(p1[4], p1[5]); w.w = cvt_pk_bf16(p1[6], p1[7]); pk[2] = __builtin_bit_cast(bf16x8, w);
          w.x = cvt_pk_bf16(p1[8], p1[9]); w.y = cvt_pk_bf16(p1[10], p1[11]); w.z = cvt_pk_bf16(p1[12], p1[13]); w.w = cvt_pk_bf16(p1[14], p1[15]); pk[3] = __builtin_bit_cast(bf16x8, w); }
        LWAIT(4, fa); VMMA(fa, 0); VREAD(fa, 2);
        LWAIT(4, fb); VMMA(fb, 1); VREAD(fb, 3);
        LWAIT(4, fa); VMMA(fa, 2);
        LWAIT(0, fb); VMMA(fb, 3);
        }
#undef DSR
#undef LWAIT
#undef KREAD
#undef KMMA
#undef VREAD
#undef VMMA
    }
#undef ATT_LOAD
#undef ATT_STORE
    float ltot; { const unsigned la = __float_as_uint(lrow); const auto rr = __builtin_amdgcn_permlane32_swap(la, la, false, false);
                  const unsigned r0 = rr[0], r1 = rr[1];
                  ltot = add2f(__uint_as_float(r0), __uint_as_float(r1)); }
    const float inv = 1.0f / ltot;
    bf16_t* op = O + (size_t)qtok * 1024 + h * 128 + 4 * hi;
#pragma unroll
    for (int d = 0; d < 4; ++d)
#pragma unroll
        for (int rg = 0; rg < 4; ++rg) { u32x2 w; w.x = cvt_pk_bf16(o[d][4 * rg] * inv, o[d][4 * rg + 1] * inv); w.y = cvt_pk_bf16(o[d][4 * rg + 2] * inv, o[d][4 * rg + 3] * inv);
            *(u32x2*)(op + 32 * d + 8 * rg) = w; }
}
}

namespace sgu {
constexpr int AROW = 136;
constexpr int A_BYTES = 256 * AROW * 2, B_BYTES = 128 * AROW * 2, ST_OFF = A_BYTES + B_BYTES, MROW = 264;
static_assert(128 * MROW * 2 <= A_BYTES, "the mixed tile is staged in the A tile's space");
__device__ __forceinline__ void phase(LAS unsigned char* lds, int G, int bx, const bf16_t* __restrict__ vT, const float* __restrict__ lnst, const float* __restrict__ lng,
                                      const float* __restrict__ lnb, const bf16_t* __restrict__ wsp, const float* __restrict__ bsp, bf16_t* U) {
    int tid_ = threadIdx.x; asm volatile("" : "+v"(tid_));
    const int tid = tid_, lane = tid & 63, r32 = lane & 31, hi = lane >> 5, wid = __builtin_amdgcn_readfirstlane(tid >> 6);
    LAS float* mus = (LAS float*)(lds + ST_OFF);
    LAS float* rss = mus + 256;
    if (bx >= 1024) return;
    u32x4 rawv[8]; f32x4 stv[8];
    const int vd = tid >> 4, vcc = tid & 15;
#define SGU_LOADV(it) do { const int c_ = (it) >> 3, g_ = (it) & 7; const bf16_t* p_ = vT + (size_t)(g_ * 256 + vd) * M + c_ * 128 + vcc * 8; \
        _Pragma("unroll") for (int i = 0; i < 8; ++i) rawv[i] = *(const u32x4*)(p_ + (size_t)(32 * i) * M); } while (0)
#define SGU_LOADST(it) do { if (tid < 128) { const float* p_ = lnst + (size_t)(((it) >> 3) * 128 + tid) * 32; \
        _Pragma("unroll") for (int i = 0; i < 8; ++i) stv[i] = *(const f32x4*)(p_ + 4 * i); } } while (0)
#define SGU_PUTST(slot) do { if (tid < 128) { float s1 = 0.f, s2 = 0.f; \
        _Pragma("unroll") for (int i = 0; i < 8; ++i) { s1 += stv[i][0] + stv[i][2]; s2 += stv[i][1] + stv[i][3]; } \
        const float mean = s1 * (1.0f / 2048.0f), var = fmaxf(s2 * (1.0f / 2048.0f) - mean * mean, 0.f); \
        mus[(slot) * 128 + tid] = mean; rss[(slot) * 128 + tid] = 1.0f / sqrtf(var + LN_EPS); } } while (0)
    SGU_LOADST(bx); SGU_LOADV(bx);
    SGU_PUTST(0);
    int gload = -1, k = 0;
    for (int it = bx; it < 1024; it += G, ++k) {
        const int c = it >> 3, g = it & 7, tokbase = c * 128, slot = k & 1;
        const bool has_next = it + G < 1024;
        if (g != gload) {
            if (gload >= 0) __syncthreads();
#pragma unroll
            for (int i = 0; i < 4; ++i) { const int ch = tid + 512 * i, t = ch >> 4, cc = ch & 15;
                *(LAS u32x4*)(lds + A_BYTES + (t * AROW + cc * 8) * 2) = *(const u32x4*)(wsp + ((size_t)g * 128 + t) * 128 + cc * 8); }
            gload = g;
        }
        __syncthreads();
#pragma unroll
        for (int i = 0; i < 8; ++i) { const int d = vd + 32 * i;
            const float gg = lng[g * 256 + d], bb = lnb[g * 256 + d];
            float v[8];
#pragma unroll
            for (int e = 0; e < 4; ++e) { const unsigned w = rawv[i][e]; v[2 * e] = __builtin_bit_cast(float, w << 16); v[2 * e + 1] = __builtin_bit_cast(float, w & 0xffff0000u); }
#pragma unroll
            for (int e = 0; e < 8; ++e) { const int sidx = slot * 128 + vcc * 8 + e; v[e] = (v[e] - mus[sidx]) * rss[sidx] * gg + bb; }
            u32x4 w; w.x = cvt_pk_bf16(v[0], v[1]); w.y = cvt_pk_bf16(v[2], v[3]); w.z = cvt_pk_bf16(v[4], v[5]); w.w = cvt_pk_bf16(v[6], v[7]);
            *(LAS u32x4*)(lds + (d * AROW + vcc * 8) * 2) = w; }
        __syncthreads();
        if (has_next) { SGU_LOADST(it + G); SGU_LOADV(it + G); }
        u32x4 uu[8];
        { const bf16_t* up = U + (size_t)(tokbase + (tid >> 5)) * SGW + g * 256 + (tid & 31) * 8;
#pragma unroll
          for (int i = 0; i < 8; ++i) uu[i] = *(const u32x4*)(up + (size_t)(16 * i) * SGW); }
        f32x16 acc[4];
#pragma unroll
        for (int tb = 0; tb < 4; ++tb)
#pragma unroll
            for (int r = 0; r < 16; ++r) acc[tb][r] = 0.f;
        const LAS unsigned char* ap = lds + ((wid * 32 + r32) * AROW + hi * 8) * 2;
        const LAS unsigned char* bp = lds + A_BYTES + (r32 * AROW + hi * 8) * 2;
#pragma unroll
        for (int ks = 0; ks < 8; ++ks) {
            const bf16x8 a = *(const LAS bf16x8*)(ap + ks * 32);
#pragma unroll
            for (int tb = 0; tb < 4; ++tb) if (16 * ks <= 32 * tb + 31) {
                const bf16x8 bq = *(const LAS bf16x8*)(bp + tb * 32 * AROW * 2 + ks * 32);
                acc[tb] = __builtin_amdgcn_mfma_f32_32x32x16_bf16(a, bq, acc[tb], 0, 0, 0);
            }
        }
        __syncthreads();
#pragma unroll
        for (int tb = 0; tb < 4; ++tb) { const int t = tb * 32 + r32; const float bias = bsp[g * 128 + t];
#pragma unroll
            for (int rg = 0; rg < 4; ++rg) { u32x2 w; w.x = cvt_pk_bf16(acc[tb][4 * rg] + bias, acc[tb][4 * rg + 1] + bias); w.y = cvt_pk_bf16(acc[tb][4 * rg + 2] + bias, acc[tb][4 * rg + 3] + bias);
                *(LAS u32x2*)(lds + (t * MROW + wid * 32 + 8 * rg + 4 * hi) * 2) = w; } }
        __syncthreads();
        { bf16_t* up = U + (size_t)(tokbase + (tid >> 5)) * SGW + g * 256 + (tid & 31) * 8;
#pragma unroll
          for (int i = 0; i < 8; ++i) { const u32x4 mm = *(const LAS u32x4*)(lds + (((tid >> 5) + 16 * i) * MROW + (tid & 31) * 8) * 2); const u32x4 u4 = uu[i];
              u32x4 w;
#pragma unroll
              for (int e = 0; e < 4; ++e) w[e] = cvt_pk_bf16(__builtin_bit_cast(float, u4[e] << 16) * __builtin_bit_cast(float, mm[e] << 16), __builtin_bit_cast(float, u4[e] & 0xffff0000u) * __builtin_bit_cast(float, mm[e] & 0xffff0000u));
              *(u32x4*)(up + (size_t)(16 * i) * SGW) = w; } }
        if (has_next) SGU_PUTST(slot ^ 1);
    }
    __syncthreads();
#undef SGU_LOADV
#undef SGU_LOADST
#undef SGU_PUTST
}
}

__device__ __forceinline__ float wave_sum(float v) {
#pragma unroll
    for (int o = 1; o < 64; o <<= 1) v += __shfl_xor(v, o);
    return v;
}
struct Src { const float* p; int ld; const float* g; };
template <class F>
__device__ __forceinline__ void conv_matrix(const F& f, bf16_t* WT, int Kd, int Nd, LAS float* scr, int gw, int NGW, int lane_, int& base) {
    (void)lane_; int lt_ = threadIdx.x; asm volatile("" : "+v"(lt_)); const int lane = lt_ & 63;
    const int nblk = Nd / 32, nitems = (Kd / 64) * nblk;
    const int lr = lane >> 3, lc = (lane & 7) * 4;
    const int it0 = (gw + NGW - base % NGW) % NGW; base += nitems;
    for (int it = it0; it < nitems; it += NGW) {
        const int kb = it / nblk, nb = it % nblk, k0 = 64 * kb, n0 = 32 * nb;
        const Src sc = f(k0, n0);
        if (sc.p) {
            f32x4 v[8]; float gg[8];
#pragma unroll
            for (int i = 0; i < 8; ++i) { const int kk = 8 * i + lr; v[i] = *(const f32x4*)(sc.p + (size_t)kk * sc.ld + lc); gg[i] = sc.g ? sc.g[kk] : 1.0f; }
#pragma unroll
            for (int i = 0; i < 8; ++i) { const int kk = 8 * i + lr; LAS float* d = scr + kk * 33 + lc; d[0] = v[i][0] * gg[i]; d[1] = v[i][1] * gg[i]; d[2] = v[i][2] * gg[i]; d[3] = v[i][3] * gg[i]; }
        } else {
#pragma unroll
            for (int i = 0; i < 8; ++i) { const int kk = 8 * i + lr; LAS float* d = scr + kk * 33 + lc; d[0] = 0.f; d[1] = 0.f; d[2] = 0.f; d[3] = 0.f; }
        }
        asm volatile("s_waitcnt lgkmcnt(0)" ::: "memory");
        const int c = lane & 7;
#pragma unroll
        for (int j = 0; j < 4; ++j) { const int n = (lane >> 3) + 8 * j; const LAS float* s = scr + (8 * c) * 33 + n;
            u32x4 o; o.x = cvt_pk_bf16(s[0 * 33], s[1 * 33]); o.y = cvt_pk_bf16(s[2 * 33], s[3 * 33]); o.z = cvt_pk_bf16(s[4 * 33], s[5 * 33]); o.w = cvt_pk_bf16(s[6 * 33], s[7 * 33]);
            *(u32x4*)(WT + (size_t)(n0 + n) * Kd + k0 + 8 * c) = o; }
        asm volatile("s_waitcnt lgkmcnt(0)" ::: "memory");
    }
}

struct Args {
    const float* x; const int* pos; const float* norm_mix; const float* norm_ffn; const float* final_norm;
    const float* w_dkv; const float* q_norm; const float* kv_norm; const float* w_uq; const float* w_ukv; const float* w_o;
    const float* w_in; const float* ln_g; const float* ln_b; const float* w_sp; const float* b_sp; const float* w_out;
    const float* w_up; const float* w_down;
    float* out; unsigned char* ws;
};

__device__ __forceinline__ void conv_set_a(const Args& a, int j, LAS float* scr, int gw, int NGW, int lane) {
    const int L = 2 * j; int base = 0;
    unsigned char* wa = a.ws + WS_WA;
    { const float* W = a.w_dkv + (size_t)j * 1024 * 448; const float* g = a.norm_mix + L * 1024;
      auto f = [=](int k0, int n0) -> Src { int c;
          if (n0 < 256) c = n0; else { const int l = n0 - 256, h2 = l >> 7, ll = l & 127; c = ll < 64 ? 256 + h2 * 64 + ll : (ll < 96 ? 384 + h2 * 32 + (ll - 64) : -1); }
          return c < 0 ? Src{nullptr, 0, nullptr} : Src{W + (size_t)k0 * 448 + c, 448, g + k0}; };
      conv_matrix(f, (bf16_t*)(wa + WA_LAT), 1024, 512, scr, gw, NGW, lane, base); }
    { const float* Wq = a.w_uq + (size_t)j * 256 * 1536; const float* Wkv = a.w_ukv + (size_t)j * 128 * 2048; const float* gq = a.q_norm + j * 256; const float* gk = a.kv_norm + j * 128;
      auto f = [=](int k0, int n0) -> Src {
          if (n0 < 1536) { if (k0 >= 256) return Src{nullptr, 0, nullptr}; int c;
              if (n0 < 1024) c = (n0 >> 7) * 192 + (n0 & 127); else { const int l = n0 - 1024, uu = l >> 8, ll = l & 255, half = ll >> 7, hh = (ll & 127) >> 5; c = (uu * 4 + hh) * 192 + 128 + half * 32; }
              return Src{Wq + (size_t)k0 * 1536 + c, 1536, gq + k0}; }
          if (k0 < 256) return Src{nullptr, 0, nullptr}; const int l = n0 - 1536;
          return Src{Wkv + (size_t)(k0 - 256) * 2048 + (l >> 7) * 256 + (l & 127), 2048, gk + (k0 - 256)}; };
      conv_matrix(f, (bf16_t*)(wa + WA_QK), LATK, 2560, scr, gw, NGW, lane, base); }
    { const float* Wkv = a.w_ukv + (size_t)j * 128 * 2048; const float* gk = a.kv_norm + j * 128;
      auto f = [=](int k0, int n0) -> Src { if (k0 < 256) return Src{nullptr, 0, nullptr};
          return Src{Wkv + (size_t)(k0 - 256) * 2048 + (n0 >> 7) * 256 + 128 + (n0 & 127), 2048, gk + (k0 - 256)}; };
      conv_matrix(f, (bf16_t*)(wa + WA_V), LATK, 1024, scr, gw, NGW, lane, base); }
    { const float* W = a.w_o + (size_t)j * 1024 * 1024;
      auto f = [=](int k0, int n0) -> Src { return Src{W + (size_t)k0 * 1024 + n0, 1024, nullptr}; };
      conv_matrix(f, (bf16_t*)(wa + WA_O), 1024, 1024, scr, gw, NGW, lane, base); }
    { const float* W = a.w_up + (size_t)L * 1024 * 4096; const float* g = a.norm_ffn + L * 1024;
      auto f = [=](int k0, int n0) -> Src { return Src{W + (size_t)k0 * 4096 + n0, 4096, g + k0}; };
      conv_matrix(f, (bf16_t*)(wa + WA_UP), 1024, 4096, scr, gw, NGW, lane, base); }
    { const float* W = a.w_down + (size_t)L * 4096 * 1024;
      auto f = [=](int k0, int n0) -> Src { return Src{W + (size_t)k0 * 1024 + n0, 1024, nullptr}; };
      conv_matrix(f, (bf16_t*)(wa + WA_DN), 4096, 1024, scr, gw, NGW, lane, base); }
}
__device__ __forceinline__ void conv_set_b(const Args& a, int j, LAS float* scr, int gw, int NGW, int lane) {
    const int L = 2 * j + 1; int base = 0;
    unsigned char* wb = a.ws + WS_WB;
    { const float* W = a.w_in + (size_t)j * 1024 * 4096; const float* g = a.norm_mix + L * 1024;
      auto f = [=](int k0, int n0) -> Src { return Src{W + (size_t)k0 * 4096 + n0, 4096, g + k0}; };
      conv_matrix(f, (bf16_t*)(wb + WB_INU), 1024, 2048, scr, gw, NGW, lane, base);
      auto f2 = [=](int k0, int n0) -> Src { return Src{W + (size_t)k0 * 4096 + 2048 + n0, 4096, g + k0}; };
      conv_matrix(f2, (bf16_t*)(wb + WB_INV), 1024, 2048, scr, gw, NGW, lane, base); }
    { const float* W = a.w_out + (size_t)j * 2048 * 1024;
      auto f = [=](int k0, int n0) -> Src { return Src{W + (size_t)k0 * 1024 + n0, 1024, nullptr}; };
      conv_matrix(f, (bf16_t*)(wb + WB_OUT), 2048, 1024, scr, gw, NGW, lane, base); }
    { const float* W = a.w_up + (size_t)L * 1024 * 4096; const float* g = a.norm_ffn + L * 1024;
      auto f = [=](int k0, int n0) -> Src { return Src{W + (size_t)k0 * 4096 + n0, 4096, g + k0}; };
      conv_matrix(f, (bf16_t*)(wb + WB_UP), 1024, 4096, scr, gw, NGW, lane, base); }
    { const float* W = a.w_down + (size_t)L * 4096 * 1024;
      auto f = [=](int k0, int n0) -> Src { return Src{W + (size_t)k0 * 1024 + n0, 1024, nullptr}; };
      conv_matrix(f, (bf16_t*)(wb + WB_DN), 4096, 1024, scr, gw, NGW, lane, base); }
}

#define XB_TMO      128
#define XB_XCNT(j)  (256  + 64 * (j))
#define XB_XSUB(j)  (1280 + 64 * (j))
#define XB_XGEN(j)  (2304 + 64 * (j))
#define XB_TOP      3328
#define XB_TOPGEN   3392
#define XCD_BAR_WORDS 3456
#define XB_SPIN_CAP (1u << 22)
__device__ __forceinline__ unsigned xb_ld(unsigned* p)              { return __hip_atomic_load(p, __ATOMIC_RELAXED, __HIP_MEMORY_SCOPE_AGENT); }
__device__ __forceinline__ unsigned xb_add(unsigned* p, unsigned v) { return __hip_atomic_fetch_add(p, v, __ATOMIC_RELAXED, __HIP_MEMORY_SCOPE_AGENT); }
__device__ __forceinline__ unsigned xb_xcc_id() { return (unsigned)__builtin_amdgcn_s_getreg((3 << 11) | 20) & 0xFu; }
#define XB_SPIN(cond, bar) do { unsigned _sp = 0; while (cond) { __builtin_amdgcn_s_sleep(1); \
    if ((++_sp & 255u) == 0u) { if (xb_ld(&(bar)[XB_TMO])) break; if (_sp > XB_SPIN_CAP) { atomicAdd(&(bar)[XB_TMO], 1u); break; } } } } while (0)
struct XcdBarrier { unsigned* bar; unsigned x; volatile LAS unsigned* st; };
__device__ __forceinline__ XcdBarrier xcd_barrier_post(unsigned* bar, volatile LAS unsigned* st) {
    XcdBarrier b; b.bar = bar; b.x = xb_xcc_id(); b.st = st;
    if (threadIdx.x == 0) (void)xb_add(&bar[XB_XCNT(b.x)], 1u);
    return b;
}
__device__ __forceinline__ void xcd_barrier_complete(unsigned* bar, unsigned x, unsigned& nloc, unsigned& nx) {
    const unsigned G = gridDim.x * gridDim.y * gridDim.z;
    unsigned sum, cnt, mine, sp = 0u;
    for (;;) {
        sum = 0u; cnt = 0u; mine = 0u;
#pragma unroll
        for (unsigned j = 0; j < 16; ++j) { const unsigned c = xb_ld(&bar[XB_XCNT(j)]); sum += c; cnt += (c > 0u) ? 1u : 0u; mine = (j == x) ? c : mine; }
        if (sum == G) break;
        __builtin_amdgcn_s_sleep(1);
        if ((++sp & 255u) == 0u) { if (xb_ld(&bar[XB_TMO])) break; if (sp > XB_SPIN_CAP) { atomicAdd(&bar[XB_TMO], 1u); break; } }
    }
    nloc = mine > 0u ? mine : 1u; nx = cnt > 0u ? cnt : 1u;
}
__device__ __forceinline__ void xcd_barrier(const XcdBarrier& b) {
    asm volatile("s_waitcnt vmcnt(0)" ::: "memory");
    __syncthreads();
    if (threadIdx.x == 0) {
        unsigned* bar = b.bar;
        __builtin_amdgcn_s_waitcnt(0);
        unsigned nloc = b.st[0], nx = b.st[1];
        if (nloc == 0u) { xcd_barrier_complete(bar, b.x, nloc, nx); b.st[0] = nloc; b.st[1] = nx; }
        const unsigned old = xb_add(&bar[XB_XSUB(b.x)], 1u);
        const unsigned gen = old / nloc;
        if (old + 1u == (gen + 1u) * nloc) {
            __builtin_amdgcn_fence(__ATOMIC_RELEASE, "agent");
            asm volatile("s_waitcnt vmcnt(0)" ::: "memory");
            const unsigned og = xb_add(&bar[XB_TOP], 1u);
            const unsigned tg = og / nx;
            if (og + 1u == (tg + 1u) * nx) xb_add(&bar[XB_TOPGEN], 1u);
            else XB_SPIN(xb_ld(&bar[XB_TOPGEN]) == tg, bar);
            __builtin_amdgcn_fence(__ATOMIC_ACQUIRE, "agent");
            xb_add(&bar[XB_XGEN(b.x)], 1u);
            asm volatile("s_waitcnt vmcnt(0)" ::: "memory");
        } else {
            XB_SPIN(xb_ld(&bar[XB_XGEN(b.x)]) == gen, bar);
            __builtin_amdgcn_fence(__ATOMIC_ACQUIRE, "agent");
            asm volatile("s_waitcnt vmcnt(0)" ::: "memory");
        }
    }
    __syncthreads();
}

#ifndef ECHO_MASK
#define ECHO_MASK 0u
#endif
#define PH_DONE(cls) do { if (ECHO_MASK) { const unsigned long long t_ = __builtin_amdgcn_s_memrealtime(); if (ECHO_MASK & (1u << (cls))) echo_ += t_ - tprev_; tprev_ = t_; } } while (0)
__global__ void __launch_bounds__(512, 2) mega_fwd(Args a) {
    extern __shared__ __attribute__((aligned(16))) unsigned char lds_raw[];
    LAS unsigned char* lds = (LAS unsigned char*)lds_raw;
    cg::grid_group grid = cg::this_grid();
    const int tid = threadIdx.x, lane = tid & 63, wave = __builtin_amdgcn_readfirstlane(tid >> 6);
    const int G = gridDim.x, bx = blockIdx.x;
    const int gw = bx * 8 + wave, NGW = G * 8;
    unsigned char* ws = a.ws;
    float* ssqx = (float*)(ws + WS_SSQX); float* ssqq = (float*)(ws + WS_SSQQ); float* ssqkv = (float*)(ws + WS_SSQKV); float* lnst = (float*)(ws + WS_LNST);
    float* cst = (float*)(ws + WS_COS); float* snt = (float*)(ws + WS_SIN);
    bf16_t* KR = (bf16_t*)(ws + WS_KR); bf16_t* WSP = (bf16_t*)(ws + WS_WSP);
    bf16_t* XB = (bf16_t*)(ws + WS_XB);
    unsigned char* hb = ws + WS_HB; unsigned char* wa = ws + WS_WA; unsigned char* wb = ws + WS_WB;
    bf16_t* HB = (bf16_t*)hb;
    bf16_t* LAT = (bf16_t*)(hb + HB_LAT); bf16_t* QN = (bf16_t*)(hb + HB_QN); bf16_t* QR = (bf16_t*)(hb + HB_QR); bf16_t* KN = (bf16_t*)(hb + HB_KN); bf16_t* VT = (bf16_t*)(hb + HB_VT);
    bf16_t* UB = (bf16_t*)(hb + HB_U); bf16_t* VTS = (bf16_t*)(hb + HB_VTS);
    float* X32 = a.out;
    LAS float* scr = (LAS float*)(lds + wave * 16384);
    volatile LAS unsigned* MISC = (volatile LAS unsigned*)(lds + 131072);
    if (tid < 64) MISC[tid] = 0u;
    unsigned* ctl = (unsigned*)(ws + WS_CTL);
    if (bx == 0) for (int i = tid; i < 8192; i += 512) __hip_atomic_store(ctl + i, 0u, __ATOMIC_RELAXED, __HIP_MEMORY_SCOPE_AGENT);
    __syncthreads();

    unsigned long long tprev_ = ECHO_MASK ? __builtin_amdgcn_s_memrealtime() : 0ull, echo_ = 0ull;
    conv_set_a(a, 0, scr, gw, NGW, lane);
    for (int i = gw * 64 + lane; i < 2 * 8 * 128 * 128; i += NGW * 64) { const int s = i & 127, t = (i >> 7) & 127; WSP[i] = (bf16_t)(cvt_pk_bf16(s <= t ? a.w_sp[i] : 0.f, 0.f) & 0xffffu); }
    for (int i = gw * 64 + lane; i < M * 32; i += NGW * 64) { const int tok = i >> 5, fi = i & 31;
        const float inv_freq = exp2f(-(float)(2 * fi) * (13.287712379549449f / 64.0f));
        const float ang = (float)a.pos[tok] * inv_freq;
        const double rev = (double)ang * 0.15915494309189535; const float fr = (float)(rev - __builtin_rint(rev));
        cst[i] = __builtin_amdgcn_cosf(fr); snt[i] = __builtin_amdgcn_sinf(fr); }
    for (int m0 = gw * 4; m0 < M; m0 += NGW * 4) {
        f32x4 xv[4][4];
#pragma unroll
        for (int q = 0; q < 4; ++q) { const f32x4* xr = (const f32x4*)(a.x + (size_t)(m0 + q) * DM) + lane;
#pragma unroll
            for (int jj = 0; jj < 4; ++jj) xv[q][jj] = xr[64 * jj]; }
#pragma unroll
        for (int q = 0; q < 4; ++q) { const int m = m0 + q;
#pragma unroll
            for (int jj = 0; jj < 4; ++jj) { const f32x4 v = xv[q][jj]; float s = dot4(v);
                u32x2 w; w.x = cvt_pk_bf16(v[0], v[1]); w.y = cvt_pk_bf16(v[2], v[3]);
                *(u32x2*)(XB + (size_t)m * DM + 256 * jj + 4 * lane) = w;
                s += __shfl_xor(s, 1); s += __shfl_xor(s, 2); s += __shfl_xor(s, 4); s += __shfl_xor(s, 8);
                if ((lane & 15) == 0) ssqx[(size_t)m * 16 + 4 * jj + (lane >> 4)] = s; } }
    }
    grid.sync(); PH_DONE(0);
    const XcdBarrier xbar = xcd_barrier_post(ctl, MISC + 8);
    if (tid == 0) { MISC[16] = xb_add(ctl + 3400 + xbar.x, 1u); MISC[17] = xbar.x; }
    int vb = bx;

    for (int L = 0; L < 4; ++L) {
        const int j = L >> 1;
        if ((L & 1) == 0) {
            { pg8::Gemm g{XB, (const bf16_t*)(wa + WA_LAT), M, 512, 1024, 1024, 1024, 1 << 30, 0, 0}; pg8::StaticOrder S; S.init(M, 512, G, vb);
              EpiLat E{LAT, KR, ssqx, ssqq, ssqkv, cst, snt};
              pg8::gemm_phase(lds, g, S, E); }
            { const int nidle = G - 128;
              if (nidle >= 64) { if (vb >= 128) conv_set_b(a, j, scr, (vb - 128) * 8 + wave, nidle * 8, lane); }
              else conv_set_b(a, j, scr, gw, NGW, lane); }
            xcd_barrier(xbar); PH_DONE(1);
            if (L == 0) {
                if (tid == 0) { bool ok = (G % 8) == 0;
                    for (int q = 0; q < 16; ++q) ok = ok && (xb_ld(ctl + 3400 + q) == (q < 8 ? (unsigned)(G / 8) : 0u));
                    MISC[18] = ok ? (MISC[16] * 8u + MISC[17]) : (unsigned)bx; }
                __syncthreads();
                vb = __builtin_amdgcn_readfirstlane((int)MISC[18]);
            }
            { pg8::Gemm g{LAT, (const bf16_t*)(wa + WA_QK), M, 2560, 256, LATK, LATK, 6, 256, 128};    pg8::StaticOrder S; S.init(M, 2560, G, vb);
              EpiQK E{QN, QR, KN, ssqq, ssqkv, cst, snt};
              pg8::gemm_phase(lds, g, S, E); }
            { pg8::Gemm g{(const bf16_t*)(wa + WA_V) + 256, LAT + 256, 1024, M, 128, LATK, LATK, 1 << 30, 0, 0};    pg8::StaticOrder S; S.init(1024, M, G, vb);
              EpiVT E{VT, ssqkv};
              pg8::gemm_phase(lds, g, S, E); }
            xcd_barrier(xbar); PH_DONE(2);
            { const int nsl = (G == 256) ? 1 : 0;
              for (int p0 = vb; p0 < 256; p0 += G) {
                  const int p = nsl ? ((p0 & 7) * 32 + (p0 >> 3)) : p0;
                  const int bh = p >> 3, pi = p & 7;
                  att::attn_unit(lds, bh >> 3, bh & 7, 15 - pi, QN, QR, KN, KR, VT, QN);
                  att::attn_unit(lds, bh >> 3, bh & 7, pi, QN, QR, KN, KR, VT, QN);
              }
              __syncthreads(); }
            xcd_barrier(xbar); PH_DONE(3);
            { pg8::Gemm g{QN, (const bf16_t*)(wa + WA_O), M, 1024, 1024, 1024, 1024, 1 << 30, 0, 0}; pg8::StaticOrder S; S.init(M, 1024, G, vb);
              EpiRes E{XB, ssqx};
              pg8::gemm_phase(lds, g, S, E); }
            xcd_barrier(xbar); PH_DONE(4);
        } else {
            { pg8::Gemm g{XB, (const bf16_t*)(wb + WB_INU), M, SGW, 1024, 1024, 1024, 1 << 30, 0, 0}; pg8::StaticOrder S; S.init(M, SGW, G, vb);
              EpiU E{UB, ssqx};
              pg8::gemm_phase(lds, g, S, E); }
            { pg8::Gemm g{(const bf16_t*)(wb + WB_INV), XB, SGW, M, 1024, 1024, 1024, 1 << 30, 0, 0}; pg8::StaticOrder S; S.init(SGW, M, G, vb);
              EpiVTS E{VTS, ssqx, lnst};
              pg8::gemm_phase(lds, g, S, E); }
            xcd_barrier(xbar); PH_DONE(5);
            { const bf16_t* wsp = WSP + (size_t)j * 8 * 128 * 128; const float* bsp = a.b_sp + j * 8 * 128;
              sgu::phase(lds, G, vb, VTS, lnst, a.ln_g + j * SGW, a.ln_b + j * SGW, wsp, bsp, UB); }
            if (L == 1) conv_set_a(a, 1, scr, gw, NGW, lane);
            xcd_barrier(xbar); PH_DONE(6);
            { pg8::Gemm g{UB, (const bf16_t*)(wb + WB_OUT), M, 1024, SGW, SGW, SGW, 1 << 30, 0, 0}; pg8::StaticOrder S; S.init(M, 1024, G, vb);
              EpiRes E{XB, ssqx};
              pg8::gemm_phase(lds, g, S, E); }
            xcd_barrier(xbar); PH_DONE(7);
        }
        unsigned char* wl = (L & 1) ? wb : wa;
        const size_t off_up = (L & 1) ? WB_UP : WA_UP, off_dn = (L & 1) ? WB_DN : WA_DN;
        { pg8::Gemm g{XB, (const bf16_t*)(wl + off_up), M, FF, 1024, 1024, 1024, 1 << 30, 0, 0}; pg8::StaticOrder S; S.init(M, FF, G, vb);
          EpiUp E{HB, ssqx};
          pg8::gemm_phase(lds, g, S, E); }
        xcd_barrier(xbar); PH_DONE(8);
        { pg8::Gemm g{HB, (const bf16_t*)(wl + off_dn), M, 1024, FF, FF, FF, 1 << 30, 0, 0}; pg8::StaticOrder S; S.init(M, 1024, G, vb);
          if (L == 3 && G == 256) {
              EpiResFinal E{XB, X32, ssqx, ctl + 4096, a.final_norm};
              pg8::gemm_phase(lds, g, S, E);
          } else {
              EpiRes E{XB, ssqx};
              pg8::gemm_phase(lds, g, S, E); } }
        if (!(L == 3 && G == 256)) { xcd_barrier(xbar); PH_DONE(9); }
    }
    int lt2_ = threadIdx.x; asm volatile("" : "+v"(lt2_)); const int lane2 = lt2_ & 63;
    if (G != 256)
    for (int m0 = gw * 4; m0 < M; m0 += NGW * 4) {
        u32x4 raw[4][2];
#pragma unroll
        for (int q = 0; q < 4; ++q) { const u32x4* xr = (const u32x4*)(XB + (size_t)(m0 + q) * DM) + lane2; raw[q][0] = xr[0]; raw[q][1] = xr[64]; }
        const f32x4 g00 = *(const f32x4*)(a.final_norm + 8 * lane2), g01 = *(const f32x4*)(a.final_norm + 8 * lane2 + 4);
        const f32x4 g10 = *(const f32x4*)(a.final_norm + 512 + 8 * lane2), g11 = *(const f32x4*)(a.final_norm + 512 + 8 * lane2 + 4);
#pragma unroll
        for (int q = 0; q < 4; ++q) { const int m = m0 + q;
            float v[16]; float s = 0.f;
#pragma unroll
            for (int jj = 0; jj < 2; ++jj) { const u32x4 o = raw[q][jj];
#pragma unroll
                for (int e = 0; e < 4; ++e) { v[8 * jj + 2 * e] = __builtin_bit_cast(float, o[e] << 16); v[8 * jj + 2 * e + 1] = __builtin_bit_cast(float, o[e] & 0xffff0000u); } }
#pragma unroll
            for (int e = 0; e < 16; ++e) s += v[e] * v[e];
            const float r = 1.0f / sqrtf(wave_sum(s) * (1.0f / 1024.0f) + NORM_EPS);
            float* op = X32 + (size_t)m * DM + 8 * lane2;
            *(f32x4*)op = (f32x4){v[0] * r * g00[0], v[1] * r * g00[1], v[2] * r * g00[2], v[3] * r * g00[3]};
            *(f32x4*)(op + 4) = (f32x4){v[4] * r * g01[0], v[5] * r * g01[1], v[6] * r * g01[2], v[7] * r * g01[3]};
            *(f32x4*)(op + 512) = (f32x4){v[8] * r * g10[0], v[9] * r * g10[1], v[10] * r * g10[2], v[11] * r * g10[3]};
            *(f32x4*)(op + 516) = (f32x4){v[12] * r * g11[0], v[13] * r * g11[1], v[14] * r * g11[2], v[15] * r * g11[3]}; }
    }
    if (ECHO_MASK) { PH_DONE(10); if (bx == 0 && tid < 64) { const unsigned long long t0_ = __builtin_amdgcn_s_memrealtime(); while (__builtin_amdgcn_s_memrealtime() - t0_ < echo_) __builtin_amdgcn_s_sleep(8); } }
}

extern "C" void kernel_launch(void* const* d_in, const int* in_sizes, int n_in, void* d_out, int out_size, void* d_ws, size_t ws_size, hipStream_t stream) {
    static int grid = 0;
    if (grid == 0) {
        if (n_in != 19 || out_size != M * DM || ws_size < WS_END) { fprintf(stderr, "kernel_launch: unexpected shapes (n_in %d out %d ws %zu)\n", n_in, out_size, ws_size); grid = -1; return; }
        int dev = 0, cus = 0, per_cu = 0;
        hipGetDevice(&dev); hipDeviceGetAttribute(&cus, hipDeviceAttributeMultiprocessorCount, dev);
        hipFuncSetAttribute((const void*)mega_fwd, hipFuncAttributeMaxDynamicSharedMemorySize, LDS_BYTES);
        hipOccupancyMaxActiveBlocksPerMultiprocessor(&per_cu, (const void*)mega_fwd, 512, LDS_BYTES);
        if (per_cu < 1) { fprintf(stderr, "kernel_launch: occupancy query returned %d\n", per_cu); per_cu = 1; }
        grid = cus * per_cu;
    }
    if (grid < 0) return;
    Args a{};
    a.x = (const float*)d_in[0]; a.pos = (const int*)d_in[1]; a.norm_mix = (const float*)d_in[2]; a.norm_ffn = (const float*)d_in[3]; a.final_norm = (const float*)d_in[4];
    a.w_dkv = (const float*)d_in[5]; a.q_norm = (const float*)d_in[6]; a.kv_norm = (const float*)d_in[7]; a.w_uq = (const float*)d_in[8]; a.w_ukv = (const float*)d_in[9]; a.w_o = (const float*)d_in[10];
    a.w_in = (const float*)d_in[11]; a.ln_g = (const float*)d_in[12]; a.ln_b = (const float*)d_in[13]; a.w_sp = (const float*)d_in[14]; a.b_sp = (const float*)d_in[15]; a.w_out = (const float*)d_in[16];
    a.w_up = (const float*)d_in[17]; a.w_down = (const float*)d_in[18];
    a.out = (float*)d_out; a.ws = (unsigned char*)d_ws;
    void* args[] = {&a};
    hipError_t e = hipLaunchCooperativeKernel((const void*)mega_fwd, dim3(grid), dim3(512), args, LDS_BYTES, stream);
    if (e != hipSuccess) fprintf(stderr, "cooperative launch failed: %s (grid %d)\n", hipGetErrorString(e), grid);
}
```
